# Optimizing an MI355X kernel written in HIP

```python
import math
import jax, jax.numpy as jnp
from jax import lax
import numpy as np

D_MODEL = 1024
BATCH = 32
SEQ = 256
DEPTH = 4
DEC_BATCH = 2
DEC_SEQ = 4096
PAST_LEN = 512

GRID_W = 64
EPS = 1e-6
Q_BLOCK = 128
ROPE_BASE = 10000.0

CHUNK = 128
SG_WIDTH = 512
SG_GROUPS = 8
SG_GROUP_DIM = SG_WIDTH // SG_GROUPS
DIFF_HEADS = 4
DIFF_HEAD_DIM = 64
DIFF_WIDTH = DIFF_HEADS * 2 * DIFF_HEAD_DIM
NA_HEADS = 8
NA_HEAD_DIM = 64
NA_WIDTH = NA_HEADS * NA_HEAD_DIM
NA_WIN_R = 8
NA_WIN_C = 16
FNET_GROUPS = 4
FNET_WIDTH = D_MODEL
FNET_GROUP_DIM = FNET_WIDTH // FNET_GROUPS

N_BRANCH = 4
IN_SIZES = (SG_WIDTH, SG_WIDTH, SG_WIDTH,
            DIFF_WIDTH, DIFF_WIDTH, DIFF_WIDTH, DIFF_WIDTH,
            NA_WIDTH, NA_WIDTH, NA_WIDTH, NA_WIDTH,
            FNET_WIDTH, N_BRANCH * D_MODEL)
IN_WIDTH = sum(IN_SIZES)
IN_SPLITS = tuple(int(v) for v in np.cumsum(IN_SIZES)[:-1])

kernel_name = "hybrid_diffusion_gated_branches_step"


def rms_norm(x, g):
    xf = x.astype(jnp.float32)
    y = xf * lax.rsqrt(jnp.mean(xf * xf, axis=-1, keepdims=True) + EPS)
    return (y * g.astype(jnp.float32)).astype(x.dtype)


def axial_rope(x, n_tokens):
    dh = x.shape[-1]
    half = dh // 2
    nf = half // 2
    t = jnp.arange(n_tokens)
    row = (t // GRID_W).astype(jnp.float32)
    col = (t % GRID_W).astype(jnp.float32)
    inv = ROPE_BASE ** (-jnp.arange(nf, dtype=jnp.float32) / nf)

    def rot(xp, pos):
        ang = pos[:, None] * inv[None, :]
        cos = jnp.cos(ang)[None, :, None, None, :]
        sin = jnp.sin(ang)[None, :, None, None, :]
        x1, x2 = xp[..., :nf], xp[..., nf:]
        return jnp.concatenate([x1 * cos - x2 * sin, x2 * cos + x1 * sin], axis=-1)

    xf = x.astype(jnp.float32)
    return jnp.concatenate([rot(xf[..., :half], row), rot(xf[..., half:], col)], axis=-1).astype(x.dtype)


def _query_blocks(q):
    b, sq = q.shape[:2]
    return jnp.moveaxis(q.reshape((b, sq // Q_BLOCK, Q_BLOCK) + q.shape[2:]), 1, 0)


def _merge_blocks(o):
    o = jnp.moveaxis(o, 0, 1)
    return o.reshape((o.shape[0], o.shape[1] * o.shape[2]) + o.shape[3:])


def diff_attention(q, k, v, lam):
    scale = DIFF_HEAD_DIM ** -0.5

    def block(qb):
        s = jnp.einsum('bqhmd,bkhmd->bhmqk', qb, k, preferred_element_type=jnp.float32) * scale
        p = jax.nn.softmax(s, axis=-1)
        a = p[:, :, 0] - lam * p[:, :, 1]
        return jnp.einsum('bhqk,bkhe->bqhe', a.astype(v.dtype), v)

    return _merge_blocks(lax.map(block, _query_blocks(q)))


def context_attention(q, k, v):
    scale = q.shape[-1] ** -0.5

    def block(qb):
        s = jnp.einsum('bqhd,bkhd->bhqk', qb, k, preferred_element_type=jnp.float32) * scale
        p = jax.nn.softmax(s, axis=-1).astype(v.dtype)
        return jnp.einsum('bhqk,bkhd->bqhd', p, v)

    return _merge_blocks(lax.map(block, _query_blocks(q)))


def neighbourhood_attention(q, k, v, ck, cv, rpb):
    b, s, h, dh = q.shape
    rows = s // GRID_W
    kr = min(NA_WIN_R, rows)
    scale = dh ** -0.5
    r = jnp.arange(rows)
    r0 = jnp.clip(r - kr // 2, 0, rows - kr)
    row_idx = r0[:, None] + jnp.arange(kr)[None, :]
    c = jnp.arange(GRID_W)
    c0 = jnp.clip(c - NA_WIN_C // 2, 0, GRID_W - NA_WIN_C)
    in_win = (c[None, :] >= c0[:, None]) & (c[None, :] < c0[:, None] + NA_WIN_C)

    qg = q.reshape(b, rows, GRID_W, h, dh)
    kg = k.reshape(b, rows, GRID_W, h, dh)[:, row_idx]
    vg = v.reshape(b, rows, GRID_W, h, dh)[:, row_idx]

    s_loc = jnp.einsum('brqhd,brjkhd->brhqjk', qg, kg, preferred_element_type=jnp.float32) * scale
    dr = row_idx - r[:, None]
    dc = jnp.clip(c[None, :] - c[:, None], -(NA_WIN_C - 1), NA_WIN_C - 1)
    bias = rpb[:, dr[:, :, None, None] + NA_WIN_R - 1, dc[None, None] + NA_WIN_C - 1]
    bias = jnp.transpose(bias, (1, 0, 3, 2, 4)).astype(jnp.float32)
    s_loc = jnp.where(in_win[None, None, None, :, None, :], s_loc + bias[None], -jnp.inf)
    s_loc = s_loc.reshape(b, rows, h, GRID_W, kr * GRID_W)

    s_ctx = jnp.einsum('brqhd,bkhd->brhqk', qg, ck, preferred_element_type=jnp.float32) * scale
    p = jax.nn.softmax(jnp.concatenate([s_loc, s_ctx], axis=-1), axis=-1).astype(v.dtype)
    p_loc = p[..., :kr * GRID_W].reshape(b, rows, h, GRID_W, kr, GRID_W)
    p_ctx = p[..., kr * GRID_W:]
    out = (jnp.einsum('brhqjk,brjkhd->brqhd', p_loc, vg)
           + jnp.einsum('brhqk,bkhd->brqhd', p_ctx, cv))
    return out.reshape(b, s, h, dh)


def spatial_gating(u, v, g_v, w_s, b_s):
    b, l, _ = v.shape
    vn = rms_norm(v, g_v).reshape(b, l // CHUNK, CHUNK, SG_GROUPS, SG_GROUP_DIM)
    s = jnp.einsum('gpq,bnqgc->bnpgc', w_s, vn) + b_s.T[None, None, :, :, None]
    return u * s.reshape(b, l, SG_WIDTH)


def fourier_mix(h):
    b, l, _ = h.shape
    hg = h.astype(jnp.float32).reshape(b, l, FNET_GROUPS, FNET_GROUP_DIM)
    f = jnp.fft.fft2(hg, axes=(1, 3), norm='ortho').real
    return f.reshape(b, l, FNET_WIDTH).astype(h.dtype)


def trunk_layer(x, cond, l, lp, ctx):
    (w_mod, b_mod, g_pre, g_post, w_in, sg_norm_g, sg_w, sg_b, lq1, lk1, lq2, lk2, subln_g, rpb,
     p_sg, p_diff, p_na, p_fnet, w_o) = lp
    b, s, _ = x.shape
    shift, scale, gate = jnp.split(jax.nn.silu(cond) @ w_mod + b_mod, 3, axis=-1)
    h = rms_norm(x, g_pre) * (1 + scale) + shift
    (sg_u, sg_v, sg_gate, dq, dk, dv, d_gate, nq, nk, nv, n_gate, f_gate, merge) = jnp.split(
        h @ w_in, IN_SPLITS, axis=-1)

    y_sg = spatial_gating(sg_u, sg_v, sg_norm_g, sg_w, sg_b)

    dq = dq.reshape(b, s, DIFF_HEADS, 2, DIFF_HEAD_DIM)
    dk = dk.reshape(b, s, DIFF_HEADS, 2, DIFF_HEAD_DIM)
    dv = dv.reshape(b, s, DIFF_HEADS, 2 * DIFF_HEAD_DIM)
    nq = nq.reshape(b, s, NA_HEADS, NA_HEAD_DIM)
    nk = nk.reshape(b, s, NA_HEADS, NA_HEAD_DIM)
    nv = nv.reshape(b, s, NA_HEADS, NA_HEAD_DIM)
    lam_init = 0.8 - 0.6 * math.exp(-0.3 * l)
    lam = (jnp.exp(jnp.sum(lq1.astype(jnp.float32) * lk1.astype(jnp.float32)))
           - jnp.exp(jnp.sum(lq2.astype(jnp.float32) * lk2.astype(jnp.float32))) + lam_init)

    if ctx is None:
        new_ctx = (dk.reshape(b, s, DIFF_HEADS, 2 * DIFF_HEAD_DIM), dv, nk, nv)
        y_diff = diff_attention(dq, dk, dv, lam)
        y_na = context_attention(nq, nk, nv)
    else:
        ck_d, cv_d, ck_n, cv_n = ctx
        n_ctx = ck_d.shape[1]
        dq = axial_rope(dq, s)
        dk = axial_rope(dk, s)
        k_all = jnp.concatenate([dk, ck_d.reshape(b, n_ctx, DIFF_HEADS, 2, DIFF_HEAD_DIM)], axis=1)
        v_all = jnp.concatenate([dv, cv_d], axis=1)
        y_diff = diff_attention(dq, k_all, v_all, lam)
        y_na = neighbourhood_attention(nq, nk, nv, ck_n, cv_n, rpb)
        new_ctx = None

    y_diff = (rms_norm(y_diff, subln_g) * (1 - lam_init)).reshape(b, s, DIFF_WIDTH)
    y_na = y_na.reshape(b, s, NA_WIDTH)
    y_f = fourier_mix(h)

    g = jax.nn.sigmoid(merge.reshape(b, s, N_BRANCH, D_MODEL))
    mixed = (g[..., 0, :] * ((y_sg * jax.nn.silu(sg_gate)) @ p_sg)
             + g[..., 1, :] * ((y_diff * jax.nn.silu(d_gate)) @ p_diff)
             + g[..., 2, :] * ((y_na * jax.nn.silu(n_gate)) @ p_na)
             + g[..., 3, :] * ((y_f * jax.nn.silu(f_gate)) @ p_fnet))
    out = rms_norm(mixed @ w_o, g_post)
    return x + gate * out, new_ctx


def setup_inputs(seed: int = 0) -> dict:
    key = jax.random.key(seed)
    ks = jax.random.split(key, 32)
    D = D_MODEL

    def nrm(k, shape, s):
        return jax.random.normal(k, shape, jnp.float32) * s

    return {
        "x_prompt": nrm(ks[0], (BATCH, SEQ, D), 1.0),
        "x_sample": nrm(ks[1], (DEC_BATCH, DEC_SEQ, D), 1.0),
        "cache_diff_k": nrm(ks[2], (DEC_BATCH, DEPTH, PAST_LEN, DIFF_HEADS, 2 * DIFF_HEAD_DIM), 1.0),
        "cache_diff_v": nrm(ks[3], (DEC_BATCH, DEPTH, PAST_LEN, DIFF_HEADS, 2 * DIFF_HEAD_DIM), 1.0),
        "cache_na_k": nrm(ks[4], (DEC_BATCH, DEPTH, PAST_LEN, NA_HEADS, NA_HEAD_DIM), 1.0),
        "cache_na_v": nrm(ks[5], (DEC_BATCH, DEPTH, PAST_LEN, NA_HEADS, NA_HEAD_DIM), 1.0),
        "c": nrm(ks[6], (DEC_BATCH, D), 1.0),
        "c_ctx": nrm(ks[7], (D,), 1.0),
        "w_mod": nrm(ks[8], (DEPTH, D, 3 * D), 0.5 * D ** -0.5),
        "b_mod": nrm(ks[9], (DEPTH, 3 * D), 0.02),
        "g_pre": 1.0 + nrm(ks[10], (DEPTH, D), 0.02),
        "g_post": 1.0 + nrm(ks[11], (DEPTH, D), 0.02),
        "w_in": nrm(ks[12], (DEPTH, D, IN_WIDTH), D ** -0.5),
        "sg_norm_g": 1.0 + nrm(ks[13], (DEPTH, SG_WIDTH), 0.02),
        "sg_w": nrm(ks[14], (DEPTH, SG_GROUPS, CHUNK, CHUNK), CHUNK ** -0.5),
        "sg_b": 1.0 + nrm(ks[15], (DEPTH, SG_GROUPS, CHUNK), 0.1),
        "diff_lam_q1": nrm(ks[16], (DEPTH, DIFF_HEAD_DIM), 0.1),
        "diff_lam_k1": nrm(ks[17], (DEPTH, DIFF_HEAD_DIM), 0.1),
        "diff_lam_q2": nrm(ks[18], (DEPTH, DIFF_HEAD_DIM), 0.1),
        "diff_lam_k2": nrm(ks[19], (DEPTH, DIFF_HEAD_DIM), 0.1),
        "diff_subln_g": 1.0 + nrm(ks[20], (DEPTH, 2 * DIFF_HEAD_DIM), 0.02),
        "na_rpb": nrm(ks[21], (DEPTH, NA_HEADS, 2 * NA_WIN_R - 1, 2 * NA_WIN_C - 1), 0.02),
        "w_proj_sg": nrm(ks[22], (DEPTH, SG_WIDTH, D), SG_WIDTH ** -0.5),
        "w_proj_diff": nrm(ks[23], (DEPTH, DIFF_WIDTH, D), DIFF_WIDTH ** -0.5),
        "w_proj_na": nrm(ks[24], (DEPTH, NA_WIDTH, D), NA_WIDTH ** -0.5),
        "w_proj_fnet": nrm(ks[25], (DEPTH, FNET_WIDTH, D), FNET_WIDTH ** -0.5),
        "w_out": nrm(ks[26], (DEPTH, D, D), D ** -0.5),
    }


def reference(x_prompt, x_sample, cache_diff_k, cache_diff_v, cache_na_k, cache_na_v, c, c_ctx,
              w_mod, b_mod, g_pre, g_post, w_in, sg_norm_g, sg_w, sg_b,
              diff_lam_q1, diff_lam_k1, diff_lam_q2, diff_lam_k2, diff_subln_g, na_rpb,
              w_proj_sg, w_proj_diff, w_proj_na, w_proj_fnet, w_out):
    y_p = x_prompt
    y_s = x_sample
    cond_s = c[:, None, :]
    dk_list, dv_list, nk_list, nv_list = [], [], [], []
    for l in range(DEPTH):
        lp = (w_mod[l], b_mod[l], g_pre[l], g_post[l], w_in[l], sg_norm_g[l], sg_w[l], sg_b[l],
              diff_lam_q1[l], diff_lam_k1[l], diff_lam_q2[l], diff_lam_k2[l], diff_subln_g[l], na_rpb[l],
              w_proj_sg[l], w_proj_diff[l], w_proj_na[l], w_proj_fnet[l], w_out[l])
        y_p, (ndk, ndv, nnk, nnv) = trunk_layer(y_p, c_ctx, l, lp, None)
        dk_list.append(ndk)
        dv_list.append(ndv)
        nk_list.append(nnk)
        nv_list.append(nnv)
        y_s, _ = trunk_layer(y_s, cond_s, l, lp,
                             (cache_diff_k[:, l], cache_diff_v[:, l], cache_na_k[:, l], cache_na_v[:, l]))
    new_diff_k = jnp.stack(dk_list, axis=1)
    new_diff_v = jnp.stack(dv_list, axis=1)
    new_na_k = jnp.stack(nk_list, axis=1)
    new_na_v = jnp.stack(nv_list, axis=1)
    return (y_p, y_s, new_diff_k, new_diff_v, new_na_k, new_na_v)
```

```cpp
#include <hip/hip_runtime.h>
#include <hip/hip_cooperative_groups.h>
#include <cstdio>
#include <cstdint>
namespace cg = cooperative_groups;

#define LAS __attribute__((address_space(3)))
typedef unsigned short bf16_t;
typedef short bf16x8 __attribute__((ext_vector_type(8)));
typedef short s16x4 __attribute__((ext_vector_type(4)));
typedef float f32x4 __attribute__((ext_vector_type(4)));
typedef float f32x16 __attribute__((ext_vector_type(16)));
typedef unsigned u32x4 __attribute__((ext_vector_type(4)));
typedef unsigned u32x2 __attribute__((ext_vector_type(2)));

constexpr int DM = 1024, TOK = 16384, TCTX = 8192, NIN = 10752, LDACT = 9216, LDY = 2560;
constexpr int A_SGU = 0, A_SGG = 512, A_DQ = 1024, A_DK = 1536, A_DG = 2048, A_NQ = 2560, A_NK = 3072, A_NG = 3584, A_FG = 4096, A_MG = 5120;
constexpr int Y_SG = 0, Y_D = 512, Y_NA = 1024, Y_F = 1536;
constexpr float EPSN = 1e-6f;
constexpr float QSCALE = 0.125f * 1.4426950408889634f;
constexpr float LOG2E = 1.4426950408889634f;
constexpr int NTHR = 512;
constexpr int LDS_BYTES = 155648;

constexpr size_t MiB = 1u << 20;
constexpr size_t WS_WIN = 0;
constexpr size_t WS_WP = 21 * MiB;
constexpr size_t WS_WO = 26 * MiB;
constexpr size_t WS_CSL = 28 * MiB;
constexpr size_t WS_CDK = 92 * MiB, WS_CDVT = 96 * MiB, WS_CNK = 100 * MiB, WS_CNVT = 104 * MiB;
constexpr size_t WS_SMALL = 108 * MiB;
constexpr size_t WS_CS256 = WS_SMALL, WS_CSP256 = WS_SMALL + 256 * 1024, WS_ROPE = WS_SMALL + 512 * 1024, WS_RPB = WS_SMALL + 576 * 1024,
                 WS_MOD = WS_SMALL + 704 * 1024, WS_SGW = WS_SMALL + 1 * MiB;
constexpr size_t WS_ACT = 112 * MiB;
constexpr size_t WS_R1 = 400 * MiB;
constexpr size_t WS_R2 = 464 * MiB;
constexpr size_t WS_R3 = 528 * MiB;
constexpr size_t WS_YCAT = 576 * MiB;
constexpr size_t WS_END = 656 * MiB;

struct Params {
    const float* in[27];
    float* out;
    unsigned char* ws;
};
typedef const __attribute__((address_space(4))) Params* KP;
enum { I_XP = 0, I_XS, I_CDK, I_CDV, I_CNK, I_CNV, I_C, I_CCTX, I_WMOD, I_BMOD, I_GPRE, I_GPOST, I_WIN, I_SGNG, I_SGW, I_SGB,
       I_LQ1, I_LK1, I_LQ2, I_LK2, I_SUBLN, I_RPB, I_PSG, I_PDIFF, I_PNA, I_PFNET, I_WOUT };

__device__ __forceinline__ unsigned f2bf(float f) { unsigned u = __builtin_bit_cast(unsigned, f); return (u + 0x7fffu + ((u >> 16) & 1u)) >> 16; }
typedef float f32x2_t __attribute__((ext_vector_type(2))); typedef __bf16 bf16x2_t __attribute__((ext_vector_type(2)));
__device__ __forceinline__ unsigned pk2(float lo, float hi) { f32x2_t v = {lo, hi}; bf16x2_t b = __builtin_convertvector(v, bf16x2_t); return __builtin_bit_cast(unsigned, b); }
__device__ __forceinline__ float bf2f(unsigned short b) { return __builtin_bit_cast(float, (unsigned)b << 16); }
__device__ __forceinline__ float bflo(unsigned w) { return __builtin_bit_cast(float, w << 16); }
__device__ __forceinline__ float bfhi(unsigned w) { return __builtin_bit_cast(float, w & 0xffff0000u); }
__device__ __forceinline__ float wave_sum(float v) {
#pragma unroll
    for (int o = 1; o < 64; o <<= 1) v += __shfl_xor(v, o);
    return v;
}
constexpr float LOG2E_ = 1.4426950408889634f;
__device__ __forceinline__ float fexp2(float x) { return __builtin_amdgcn_exp2f(x); }
__device__ __forceinline__ float sigmoidf_(float x) { return __builtin_amdgcn_rcpf(1.0f + __builtin_amdgcn_exp2f(-LOG2E_ * x)); }
__device__ __forceinline__ float einvsig_(float x) { return 1.0f + __builtin_amdgcn_exp2f(-LOG2E_ * x); }
__device__ __forceinline__ float siluf_(float x) { return x * __builtin_amdgcn_rcpf(1.0f + __builtin_amdgcn_exp2f(-LOG2E_ * x)); }
__device__ __forceinline__ int ltid() { int t = threadIdx.x; asm volatile("" : "+v"(t)); return t; }
#if defined(__HIP_DEVICE_COMPILE__)
__device__ __forceinline__ KP kparams() { KP p = (KP)__builtin_amdgcn_kernarg_segment_ptr(); asm volatile("" : "+s"(p)); return p; }
#endif
#if defined(__HIP_DEVICE_COMPILE__)
#define KPARAMS const KP PP = kparams(); const Params P = *PP
#else
#define KPARAMS const Params P{}
#endif
__device__ __forceinline__ unsigned char* lws(const Params& P) { unsigned char* w = P.ws; asm volatile("" : "+s"(w)); return w; }
__device__ __forceinline__ int lbid() { int b = blockIdx.x; asm volatile("" : "+s"(b)); return b; }
__device__ __forceinline__ int crow(int r, int hi) { return (r & 3) + 8 * (r >> 2) + 4 * hi; }

namespace pg8 {
constexpr int BM = 256, BK = 64, HALF = 128, HTB = HALF * BK * 2, STAGE_BYTES = 8 * HTB;
__device__ __forceinline__ int lds_byte(int r, int c) { const int st = (r >> 4) * 2 + (c >> 5), rr = r & 15, cc = c & 31, ob = rr * 64 + cc * 2; return st * 1024 + (ob ^ (((ob >> 9) & 1) << 5)); }
__device__ __forceinline__ int perm32(int rho) { const int n = rho >> 4, i = rho & 15; return 8 * (i >> 2) + 4 * n + (i & 3); }
__device__ __forceinline__ void stage_rc(int b, int& R, int& C) { const int st = b / 1024, sb = b % 1024, swz = sb ^ (((sb >> 9) & 1) << 5); R = (st >> 1) * 16 + swz / 64; C = (st & 1) * 32 + (swz % 64) / 2; }
struct Unit { int pm, pn, x; };

template <class Job, class Epi>
__device__ __forceinline__ void gemm_phase(LAS unsigned char* lds, const Job& J, const Epi& E) {
    const int tid = ltid(), wid = __builtin_amdgcn_readfirstlane(tid >> 6), lane = tid & 63, wr = wid >> 2, wc = wid & 3, fr = lane & 15, fq = lane >> 4;
    const int K = J.K, nt = K / BK;
    unsigned voffA[2], voffB[2];
#pragma unroll
    for (int i = 0; i < 2; ++i) { int R, C; stage_rc(tid * 16 + i * 8192, R, C);
        const int Rb = (R & ~31) + perm32(R & 31);
        voffA[i] = (unsigned)(R * J.lda + C) * 2u; voffB[i] = (unsigned)(Rb * J.ldb + C) * 2u; }
    const size_t kstep = (size_t)(BK * 2);
    const size_t hstepA = (size_t)HALF * J.lda * 2, hstepB = (size_t)HALF * J.ldb * 2;
    const unsigned ldsw = (unsigned)wid * 1024u;
    const int aoff = lds_byte(wr * 64 + fr, fq * 8), boff = lds_byte(wc * 32 + fr, fq * 8);
#define PG8_SA(b, h) (((b) * 2 + (h)) * HTB)
#define PG8_SB(b, h) ((4 + (b) * 2 + (h)) * HTB)
#define PG8_STAGE(bufoff, gbase, voff) do { _Pragma("unroll") for (int _i = 0; _i < 2; ++_i) \
        __builtin_amdgcn_global_load_lds((const unsigned*)((const char*)(gbase) + (voff)[_i]), (LAS unsigned*)(lds + (bufoff) + ldsw + _i * 8192), 16, 0, 0); } while (0)
#define PG8_LDA(dst, b, h) do { _Pragma("unroll") for (int m = 0; m < 4; ++m) _Pragma("unroll") for (int k = 0; k < 2; ++k) dst[m][k] = *(const LAS bf16x8*)(lds + PG8_SA(b, h) + aoff + m * 2048 + k * 1024); } while (0)
#define PG8_LDB(dst, b, h) do { _Pragma("unroll") for (int n = 0; n < 2; ++n) _Pragma("unroll") for (int k = 0; k < 2; ++k) dst[n][k] = *(const LAS bf16x8*)(lds + PG8_SB(b, h) + boff + n * 2048 + k * 1024); } while (0)
#define PG8_MMA(ai, bj, At, Bt) do { __builtin_amdgcn_s_setprio(1); _Pragma("unroll") for (int m = 0; m < 4; ++m) _Pragma("unroll") for (int n = 0; n < 2; ++n) _Pragma("unroll") for (int k = 0; k < 2; ++k) \
        acc[ai][bj][m][n] = __builtin_amdgcn_mfma_f32_16x16x32_bf16(Bt[n][k], At[m][k], acc[ai][bj][m][n], 0, 0, 0); __builtin_amdgcn_s_setprio(0); } while (0)
#define PG8_WAIT_V(n) asm volatile("s_waitcnt vmcnt(" #n ")" ::: "memory")
#define PG8_WAIT_L(n) asm volatile("s_waitcnt lgkmcnt(" #n ")" ::: "memory")
#define PG8_BAR __builtin_amdgcn_s_barrier()
#define PG8_SCHED __builtin_amdgcn_sched_barrier(0)
    Unit cur, nxt; int ui = 0;
    if (!J.next(0, cur)) return;
    f32x4 acc[2][2][4][2];
#pragma unroll
    for (int a = 0; a < 2; ++a)
#pragma unroll
        for (int b = 0; b < 2; ++b)
#pragma unroll
            for (int m = 0; m < 4; ++m)
#pragma unroll
                for (int n = 0; n < 2; ++n) acc[a][b][m][n] = (f32x4){0.f, 0.f, 0.f, 0.f};
    bf16x8 At[4][2], B0[2][2], B1[2][2];
    const char* cA; const char* cB;
    J.ptrs(cur, cA, cB);
    PG8_STAGE(PG8_SB(0, 0), cB, voffB); PG8_STAGE(PG8_SB(0, 1), cB + hstepB, voffB); PG8_STAGE(PG8_SA(0, 0), cA, voffA); PG8_STAGE(PG8_SA(0, 1), cA + hstepA, voffA);
    if (wr == 1) PG8_BAR;
    PG8_WAIT_V(2); PG8_BAR;
    PG8_STAGE(PG8_SB(1, 0), cB + kstep, voffB); PG8_STAGE(PG8_SA(1, 0), cA + kstep, voffA); PG8_STAGE(PG8_SB(1, 1), cB + hstepB + kstep, voffB);
    PG8_WAIT_V(6); PG8_BAR;
    for (;;) {
        const bool has_next = J.next(ui + 1, nxt);
        const char* nA = cA; const char* nB = cB;
        if (has_next) J.ptrs(nxt, nA, nB);
        for (int t = 0; t < nt; t += 2) {
            if constexpr (Epi::HOOK) { if (E.want(t)) E.hook(acc, cur, t, wr, wc, fr, fq); }
            const bool last = (t == nt - 2);
            const char* a1 = cA + (size_t)(t + 1) * kstep;
            const char* a2 = last ? nA : cA + (size_t)(t + 2) * kstep; const char* b2 = last ? nB : cB + (size_t)(t + 2) * kstep;
            const char* a3 = a2 + kstep; const char* b3 = b2 + kstep;
            PG8_LDB(B0, 0, 0); PG8_LDB(B1, 0, 1); PG8_SCHED; PG8_LDA(At, 0, 0); PG8_STAGE(PG8_SA(1, 1), a1 + hstepA, voffA);
            PG8_WAIT_V(8); PG8_WAIT_L(0); PG8_BAR; PG8_MMA(0, 0, At, B0); PG8_MMA(0, 1, At, B1); PG8_BAR; PG8_SCHED;
            PG8_LDA(At, 0, 1); PG8_STAGE(PG8_SB(0, 0), b2, voffB); PG8_STAGE(PG8_SB(0, 1), b2 + hstepB, voffB); PG8_STAGE(PG8_SA(0, 0), a2, voffA);
            PG8_WAIT_V(8); PG8_WAIT_L(0); PG8_BAR; PG8_MMA(1, 0, At, B0); PG8_MMA(1, 1, At, B1); PG8_BAR; PG8_SCHED;
            PG8_LDB(B0, 1, 0); PG8_LDB(B1, 1, 1); PG8_SCHED; PG8_LDA(At, 1, 0); PG8_STAGE(PG8_SA(0, 1), a2 + hstepA, voffA);
            PG8_WAIT_V(8); PG8_WAIT_L(0); PG8_BAR; PG8_MMA(0, 0, At, B0); PG8_MMA(0, 1, At, B1); PG8_BAR; PG8_SCHED;
            PG8_LDA(At, 1, 1); PG8_STAGE(PG8_SB(1, 0), b3, voffB); PG8_STAGE(PG8_SB(1, 1), b3 + hstepB, voffB); PG8_STAGE(PG8_SA(1, 0), a3, voffA);
            PG8_WAIT_V(8); PG8_WAIT_L(0); PG8_BAR; PG8_MMA(1, 0, At, B0); PG8_MMA(1, 1, At, B1); PG8_BAR; PG8_SCHED;
        }
        if (wr == 0) PG8_BAR;
        E(acc, cur, wr, wc, fr, fq);
        if (!has_next) break;
#pragma unroll
        for (int a = 0; a < 2; ++a)
#pragma unroll
            for (int b = 0; b < 2; ++b)
#pragma unroll
                for (int m = 0; m < 4; ++m)
#pragma unroll
                    for (int n = 0; n < 2; ++n) acc[a][b][m][n] = (f32x4){0.f, 0.f, 0.f, 0.f};
        cur = nxt; cA = nA; cB = nB; ++ui;
        if (wr == 1) PG8_BAR;
    }
    PG8_WAIT_V(0);
    PG8_BAR;
#undef PG8_SA
#undef PG8_SB
#undef PG8_STAGE
#undef PG8_LDA
#undef PG8_LDB
#undef PG8_MMA
#undef PG8_WAIT_V
#undef PG8_WAIT_L
#undef PG8_BAR
#undef PG8_SCHED
}
}
using pg8::Unit;

struct Job {
    const bf16_t* A; const bf16_t* B; int lda, ldb, K;
    int nM, nN, nX, G, c;
    long sAm, sAn, sAx, sBm, sBn, sBx;
    int order;
    __device__ __forceinline__ bool next(int i, Unit& u) const {
        const int L = i * G + c; const int per = nM * nN;
        if (L >= per * nX) return false;
        const int x = L / per; int r = L - x * per;
        u.x = x;
        if (order == 1) {
            { const int q = per / 8, rr = per % 8, xcd = r % 8, off = r / 8; r = (xcd < rr ? xcd * (q + 1) : rr * (q + 1) + (xcd - rr) * q) + off; }
            const int nig = 8 * nN, gid = r / nig, fm = gid * 8, gsz = (nM - fm) < 8 ? (nM - fm) : 8;
            u.pm = fm + ((r % nig) % gsz); u.pn = (r % nig) / gsz;
        } else { u.pm = r % nM; u.pn = r / nM; }
        return true;
    }
    __device__ __forceinline__ void ptrs(const Unit& u, const char*& a, const char*& b) const {
        a = (const char*)(A + (long)u.pm * sAm + (long)u.pn * sAn + (long)u.x * sAx);
        b = (const char*)(B + (long)u.pm * sBm + (long)u.pn * sBn + (long)u.x * sBx);
    }
};

#define EPI_ARGS const f32x4 (&acc)[2][2][4][2], const Unit& u, int wr, int wc, int fr, int fq

struct EpiIn {
    static constexpr bool HOOK = false;
    bf16_t* ACT; float* out_dk; float* out_nk; const float* rope; int layer;
    __device__ __forceinline__ void operator()(EPI_ARGS) const {
        const int seg = u.pn >> 1; const bool lat = u.pm >= 32;
        int mode = 0;
        if (seg == 8 || seg == 9) mode = 1;
        else if (seg >= 10) mode = 2;
        else if (seg == 2 || seg == 5) mode = 3;
        const bool dorope = lat && (seg == 2 || seg == 3);
        float* fo = nullptr;
        if (!lat && seg == 3) fo = out_dk; else if (!lat && seg == 6) fo = out_nk;
        const int cq = wc * 32 + 8 * fq;
#pragma unroll
        for (int ai = 0; ai < 2; ++ai)
#pragma unroll
            for (int m = 0; m < 4; ++m) {
                const int rt = ai * 128 + wr * 64 + m * 16 + fr;
                const size_t row = (size_t)u.pm * 256 + rt;
                bf16_t* arow = ACT + row * LDACT + (size_t)u.pn * 256 + cq;
                f32x4 cs0 = {1.f, 1.f, 1.f, 1.f}, cs1 = cs0, sn0 = {0.f, 0.f, 0.f, 0.f}, sn1 = sn0;
                if (dorope) { const int t = (int)(row - TCTX) & 4095; const int pos = (wc & 1) ? (t & 63) : (t >> 6);
                    const float* rp = rope + pos * 32 + 8 * (fq & 1); const float sg = (fq < 2) ? -1.0f : 1.0f;
                    cs0 = *(const f32x4*)rp; cs1 = *(const f32x4*)(rp + 4); sn0 = *(const f32x4*)(rp + 16) * sg; sn1 = *(const f32x4*)(rp + 20) * sg; }
#pragma unroll
                for (int bj = 0; bj < 2; ++bj) {
                    f32x4 v0 = acc[ai][bj][m][0], v1 = acc[ai][bj][m][1];
                    if (fo) {
                        float* fp = fo + ((size_t)(u.pm * 4 + layer) * 256 + rt) * 512 + (u.pn & 1) * 256 + bj * 128 + cq;
                        *(f32x4*)fp = v0; *(f32x4*)(fp + 4) = v1;
                    }
                    if (dorope) {
                        f32x4 p0, p1;
#pragma unroll
                        for (int j = 0; j < 4; ++j) { p0[j] = __shfl_xor(v0[j], 32); p1[j] = __shfl_xor(v1[j], 32); }
                        v0 = v0 * cs0 + p0 * sn0; v1 = v1 * cs1 + p1 * sn1;
                    }
                    if (mode == 1) {
#pragma unroll
                        for (int j = 0; j < 4; ++j) { v0[j] = siluf_(v0[j]); v1[j] = siluf_(v1[j]); }
                    } else if (mode == 2) {
#pragma unroll
                        for (int j = 0; j < 4; ++j) { v0[j] = einvsig_(v0[j]); v1[j] = einvsig_(v1[j]); }
                    } else if (mode == 3) { v0 = v0 * QSCALE; v1 = v1 * QSCALE; }
                    u32x4 w; w.x = pk2(v0[0], v0[1]); w.y = pk2(v0[2], v0[3]); w.z = pk2(v1[0], v1[1]); w.w = pk2(v1[2], v1[3]);
                    *(u32x4*)(arow + bj * 128) = w;
                }
            }
    }
};
struct EpiInT {
    static constexpr bool HOOK = false;
    bf16_t* XT; float* out_dv; float* out_nv; int layer;
    __device__ __forceinline__ void operator()(EPI_ARGS) const {
        float* fo = nullptr;
        if (u.pn < 32 && u.pm >= 2) fo = (u.pm < 4) ? out_dv : out_nv;
        const int cq = wc * 32 + 8 * fq;
#pragma unroll
        for (int ai = 0; ai < 2; ++ai)
#pragma unroll
            for (int m = 0; m < 4; ++m) {
                const int rt = ai * 128 + wr * 64 + m * 16 + fr;
                const int feat = u.pm * 256 + rt;
                bf16_t* xrow = XT + (size_t)feat * TOK + (size_t)u.pn * 256 + cq;
#pragma unroll
                for (int bj = 0; bj < 2; ++bj) {
                    const f32x4 v0 = acc[ai][bj][m][0], v1 = acc[ai][bj][m][1];
                    u32x4 w; w.x = pk2(v0[0], v0[1]); w.y = pk2(v0[2], v0[3]); w.z = pk2(v1[0], v1[1]); w.w = pk2(v1[2], v1[3]);
                    *(u32x4*)(xrow + bj * 128) = w;
                    if (fo) { const int s0 = bj * 128 + cq; const int f512 = feat & 511;
                        float* fp = fo + ((size_t)(u.pn * 4 + layer) * 256 + s0) * 512 + f512;
                        fp[0] = v0[0]; fp[512] = v0[1]; fp[1024] = v0[2]; fp[1536] = v0[3];
                        fp[2048] = v1[0]; fp[2560] = v1[1]; fp[3072] = v1[2]; fp[3584] = v1[3]; }
                }
            }
    }
};
struct EpiCdft {
    static constexpr bool HOOK = false;
    bf16_t* YTC; bf16_t* YTL;
    __device__ __forceinline__ void operator()(EPI_ARGS) const {
        const int g = u.pm >> 1, part = u.pm & 1;
        bf16_t* base; size_t ld;
        if (u.pn < 32) { base = YTC + ((size_t)u.pn * 1024 + g * 256) * 512 + part * 256; ld = 512; }
        else { const int q = u.pn - 32; base = YTL + ((size_t)(q >> 4) * 1024 + g * 256) * 8192 + part * 4096 + (q & 15) * 256; ld = 8192; }
#pragma unroll
        for (int ai = 0; ai < 2; ++ai)
#pragma unroll
            for (int m = 0; m < 4; ++m) {
                const int rt = ai * 128 + wr * 64 + m * 16 + fr;
                bf16_t* yrow = base + (size_t)rt * ld + wc * 32 + 8 * fq;
#pragma unroll
                for (int bj = 0; bj < 2; ++bj) { const f32x4 v0 = acc[ai][bj][m][0], v1 = acc[ai][bj][m][1];
                    u32x4 w; w.x = pk2(v0[0], v0[1]); w.y = pk2(v0[2], v0[3]); w.z = pk2(v1[0], v1[1]); w.w = pk2(v1[2], v1[3]);
                    *(u32x4*)(yrow + bj * 128) = w; }
            }
    }
};
struct EpiPdftCtx {
    static constexpr bool HOOK = false;
    const bf16_t* ACT; bf16_t* YCAT; int tokbase, xstride;
    __device__ __forceinline__ void operator()(EPI_ARGS) const {
        const unsigned r0 = (unsigned)tokbase + (unsigned)u.x * xstride + (unsigned)u.pm * 256 + wr * 64 + fr;
        const unsigned c0 = u.pn * 256 + wc * 32 + 8 * fq;
#pragma unroll
        for (int ai = 0; ai < 2; ++ai) {
            u32x4 gt[4][2];
#pragma unroll
            for (int m = 0; m < 4; ++m)
#pragma unroll
                for (int bj = 0; bj < 2; ++bj) gt[m][bj] = *(const u32x4*)(ACT + (size_t)(r0 + ai * 128 + m * 16) * LDACT + A_FG + c0 + bj * 128);
#pragma unroll
            for (int m = 0; m < 4; ++m)
#pragma unroll
                for (int bj = 0; bj < 2; ++bj) { const f32x4 v0 = acc[ai][bj][m][0], v1 = acc[ai][bj][m][1]; const u32x4 g = gt[m][bj];
                    u32x4 w; w.x = pk2(v0[0] * bflo(g.x), v0[1] * bfhi(g.x)); w.y = pk2(v0[2] * bflo(g.y), v0[3] * bfhi(g.y));
                    w.z = pk2(v1[0] * bflo(g.z), v1[1] * bfhi(g.z)); w.w = pk2(v1[2] * bflo(g.w), v1[3] * bfhi(g.w));
                    *(u32x4*)(YCAT + (size_t)(r0 + ai * 128 + m * 16) * LDY + Y_F + c0 + bj * 128) = w; }
        }
    }
};
struct EpiPdftLat {
    static constexpr bool HOOK = false;
    float* PF;
    __device__ __forceinline__ void operator()(EPI_ARGS) const {
        const int part = u.x >> 1, b = u.x & 1;
#pragma unroll
        for (int ai = 0; ai < 2; ++ai)
#pragma unroll
            for (int m = 0; m < 4; ++m) {
                const int rt = ai * 128 + wr * 64 + m * 16 + fr;
                float* prow = PF + ((size_t)part * 8192 + (size_t)b * 4096 + (size_t)u.pm * 256 + rt) * 1024 + u.pn * 256 + wc * 32 + 8 * fq;
#pragma unroll
                for (int bj = 0; bj < 2; ++bj) { *(f32x4*)(prow + bj * 128) = acc[ai][bj][m][0]; *(f32x4*)(prow + bj * 128 + 4) = acc[ai][bj][m][1]; }
            }
    }
};
struct EpiMix {
    static constexpr bool HOOK = true;
    const bf16_t* ACT; bf16_t* MIXB;
    __device__ __forceinline__ bool want(int t) const { return t == 8 || t == 16 || t == 24; }
    __device__ __forceinline__ void hook(f32x4 (&acc)[2][2][4][2], const Unit& u, int t, int wr, int wc, int fr, int fq) const {
        const int b = (t >> 3) - 1;
        unsigned r0 = (unsigned)u.pm * 256 + wr * 64 + fr, cq = wc * 32 + 8 * fq;
        asm volatile("" : "+v"(r0), "+v"(cq));
        const bf16_t* gp = ACT + A_MG + b * 1024 + u.pn * 256 + cq;
        u32x4 ga[2][2][2], gb[2][2][2];
#define MIX_LD(buf, ai, mp) do { _Pragma("unroll") for (int mm = 0; mm < 2; ++mm) _Pragma("unroll") for (int bj = 0; bj < 2; ++bj) { \
            const bf16_t* p = gp + (size_t)(r0 + (ai) * 128 + ((mp) * 2 + mm) * 16) * LDACT + bj * 128; ga[buf][mm][bj] = *(const u32x4*)p; gb[buf][mm][bj] = *(const u32x4*)(p + 1024); } } while (0)
#define MIX_AP(buf, ai, mp) do { _Pragma("unroll") for (int mm = 0; mm < 2; ++mm) _Pragma("unroll") for (int bj = 0; bj < 2; ++bj) { \
            const u32x4 a = ga[buf][mm][bj], d = gb[buf][mm][bj]; f32x4& v0 = acc[ai][bj][(mp) * 2 + mm][0]; f32x4& v1 = acc[ai][bj][(mp) * 2 + mm][1]; \
            v0[0] *= bflo(d.x) * __builtin_amdgcn_rcpf(bflo(a.x)); v0[1] *= bfhi(d.x) * __builtin_amdgcn_rcpf(bfhi(a.x)); \
            v0[2] *= bflo(d.y) * __builtin_amdgcn_rcpf(bflo(a.y)); v0[3] *= bfhi(d.y) * __builtin_amdgcn_rcpf(bfhi(a.y)); \
            v1[0] *= bflo(d.z) * __builtin_amdgcn_rcpf(bflo(a.z)); v1[1] *= bfhi(d.z) * __builtin_amdgcn_rcpf(bfhi(a.z)); \
            v1[2] *= bflo(d.w) * __builtin_amdgcn_rcpf(bflo(a.w)); v1[3] *= bfhi(d.w) * __builtin_amdgcn_rcpf(bfhi(a.w)); } } while (0)
        MIX_LD(0, 0, 0); MIX_LD(1, 0, 1);
        MIX_AP(0, 0, 0); asm volatile("" ::: "memory"); MIX_LD(0, 1, 0);
        MIX_AP(1, 0, 1); asm volatile("" ::: "memory"); MIX_LD(1, 1, 1);
        MIX_AP(0, 1, 0); MIX_AP(1, 1, 1);
        asm volatile("" ::: "memory");
#undef MIX_LD
#undef MIX_AP
    }
    __device__ __forceinline__ void operator()(EPI_ARGS) const {
        const unsigned r0 = (unsigned)u.pm * 256 + wr * 64 + fr;
        const unsigned c0 = u.pn * 256 + wc * 32 + 8 * fq;
        const bf16_t* gp = ACT + A_MG + 3 * 1024 + c0;
#pragma unroll
        for (int ai = 0; ai < 2; ++ai) {
            u32x4 ga[4][2];
#pragma unroll
            for (int m = 0; m < 4; ++m)
#pragma unroll
                for (int bj = 0; bj < 2; ++bj) ga[m][bj] = *(const u32x4*)(gp + (size_t)(r0 + ai * 128 + m * 16) * LDACT + bj * 128);
#pragma unroll
            for (int m = 0; m < 4; ++m)
#pragma unroll
                for (int bj = 0; bj < 2; ++bj) { const f32x4 v0 = acc[ai][bj][m][0], v1 = acc[ai][bj][m][1]; const u32x4 a = ga[m][bj];
#define RC_(x) __builtin_amdgcn_rcpf(x)
                    u32x4 w; w.x = pk2(v0[0] * RC_(bflo(a.x)), v0[1] * RC_(bfhi(a.x))); w.y = pk2(v0[2] * RC_(bflo(a.y)), v0[3] * RC_(bfhi(a.y)));
                    w.z = pk2(v1[0] * RC_(bflo(a.z)), v1[1] * RC_(bfhi(a.z))); w.w = pk2(v1[2] * RC_(bflo(a.w)), v1[3] * RC_(bfhi(a.w)));
#undef RC_
                    *(u32x4*)(MIXB + (size_t)(r0 + ai * 128 + m * 16) * 1024 + c0 + bj * 128) = w; }
        }
    }
};
struct EpiOut {
    static constexpr bool HOOK = false;
    bf16_t* O;
    __device__ __forceinline__ void operator()(EPI_ARGS) const {
#pragma unroll
        for (int ai = 0; ai < 2; ++ai)
#pragma unroll
            for (int m = 0; m < 4; ++m) {
                const int rt = ai * 128 + wr * 64 + m * 16 + fr;
                bf16_t* orow = O + ((size_t)u.pm * 256 + rt) * 1024 + u.pn * 256 + wc * 32 + 8 * fq;
#pragma unroll
                for (int bj = 0; bj < 2; ++bj) { const f32x4 v0 = acc[ai][bj][m][0], v1 = acc[ai][bj][m][1];
                    u32x4 w; w.x = pk2(v0[0], v0[1]); w.y = pk2(v0[2], v0[3]); w.z = pk2(v1[0], v1[1]); w.w = pk2(v1[2], v1[3]);
                    *(u32x4*)(orow + bj * 128) = w; }
            }
    }
};

struct KVSrc { const bf16_t* k0; int ldk0; const bf16_t* v0; int ldv0; int n0; const bf16_t* k1; int ldk1; const bf16_t* v1; int ldv1; };

#define MFMA32(a, b, c) __builtin_amdgcn_mfma_f32_32x32x16_bf16((a), (b), (c), 0, 0, 0)

template <int DV, int KW, int MODE>
__device__ __forceinline__ void attn_core(LAS unsigned char* lds, const bf16_t* qrow, const KVSrc& S, int nT, int kcol, int vrow,
                                          const LAS float* rpbh, int dr0, int qc, f32x16 (&o)[DV / 32], float& lsum) {
    constexpr int KS = KW + 8, VS = 72, NCH = KW / 64;
    constexpr int KBYTES = 64 * KS * 2, VBYTES = KW * VS * 2, STAGE = KBYTES + VBYTES;
    static_assert(2 * STAGE <= 144 * 1024, "attention LDS");
    const int tid = ltid(), lane = tid & 63, r32 = lane & 31, hi = lane >> 5;
    u32x4 kr[NCH], vr[NCH];
#define A_GLOAD(t) do { const bf16_t* kp_; const bf16_t* vp_; int lk_, lv_; \
        if ((t) < S.n0) { kp_ = S.k0 + (size_t)(t) * 64 * S.ldk0; lk_ = S.ldk0; vp_ = S.v0 + (size_t)(t) * 64; lv_ = S.ldv0; } \
        else { kp_ = S.k1 + (size_t)((t) - S.n0) * 64 * S.ldk1; lk_ = S.ldk1; vp_ = S.v1 + (size_t)((t) - S.n0) * 64; lv_ = S.ldv1; } \
        _Pragma("unroll") for (int c_ = 0; c_ < NCH; ++c_) { const int id_ = tid + NTHR * c_; \
            kr[c_] = *(const u32x4*)(kp_ + (size_t)(id_ / (KW / 8)) * lk_ + (id_ % (KW / 8)) * 8); \
            vr[c_] = *(const u32x4*)(vp_ + (size_t)(id_ >> 3) * lv_ + (id_ & 7) * 8); } } while (0)
#define A_LSTORE(buf) do { LAS bf16_t* kt_ = (LAS bf16_t*)(lds + (buf) * STAGE); LAS bf16_t* vt_ = (LAS bf16_t*)(lds + (buf) * STAGE + KBYTES); \
        _Pragma("unroll") for (int c_ = 0; c_ < NCH; ++c_) { const int id_ = tid + NTHR * c_; \
            *(LAS u32x4*)(kt_ + (id_ / (KW / 8)) * KS + (id_ % (KW / 8)) * 8) = kr[c_]; \
            { LAS bf16_t* vd_ = vt_ + (id_ >> 3) * VS + 16 * ((id_ & 7) >> 1) + 4 * (id_ & 1); \
              *(LAS u32x2*)vd_ = (u32x2){vr[c_].x, vr[c_].y}; *(LAS u32x2*)(vd_ + 8) = (u32x2){vr[c_].z, vr[c_].w}; } } } while (0)
    bf16x8 qf[4];
#pragma unroll
    for (int d0 = 0; d0 < 4; ++d0) qf[d0] = *(const bf16x8*)(qrow + d0 * 16 + hi * 8);
    float mrun = 0.f; lsum = 0.f;
    f32x16 negm;
#pragma unroll
    for (int j = 0; j < 16; ++j) negm[j] = 0.f;
#pragma unroll
    for (int b = 0; b < DV / 32; ++b)
#pragma unroll
        for (int j = 0; j < 16; ++j) o[b][j] = 0.f;
    A_GLOAD(0); A_LSTORE(0); if (nT > 1) A_GLOAD(1); __syncthreads();
    for (int t = 0; t < nT; ++t) {
        const int buf = t & 1;
        if (t + 1 < nT) A_LSTORE(buf ^ 1);
        if (t + 2 < nT) A_GLOAD(t + 2);
        const LAS bf16_t* Kt = (const LAS bf16_t*)(lds + buf * STAGE);
        const LAS bf16_t* Vt = (const LAS bf16_t*)(lds + buf * STAGE + KBYTES);
        f32x16 p0, p1;
#pragma unroll
        for (int d0 = 0; d0 < 4; ++d0) {
            const bf16x8 a0 = *(const LAS bf16x8*)(Kt + r32 * KS + kcol + d0 * 16 + hi * 8);
            const bf16x8 a1 = *(const LAS bf16x8*)(Kt + (32 + r32) * KS + kcol + d0 * 16 + hi * 8);
            if (d0 == 0) { p0 = MFMA32(a0, qf[0], negm); p1 = MFMA32(a1, qf[0], negm); }
            else { p0 = MFMA32(a0, qf[d0], p0); p1 = MFMA32(a1, qf[d0], p1); }
        }
        if (MODE == 2 && t < 8) {
            const int c0 = min(max(qc - 8, 0), 48);
            const LAS float* rb = rpbh + (dr0 + t + 7) * 31 + 15 - qc;
#pragma unroll
            for (int j = 0; j < 16; ++j) { const int kc = crow(j, hi);
                p0[j] = (kc >= c0 && kc < c0 + 16) ? p0[j] + rb[kc] : -INFINITY;
                const int kc1 = kc + 32;
                p1[j] = (kc1 >= c0 && kc1 < c0 + 16) ? p1[j] + rb[kc1] : -INFINITY; }
        }
        float ma = __builtin_fmaxf(__builtin_fmaxf(p0[0], p0[1]), p1[0]), mb = __builtin_fmaxf(__builtin_fmaxf(p0[2], p0[3]), p1[1]);
        ma = __builtin_fmaxf(__builtin_fmaxf(ma, p1[2]), p1[3]);
#pragma unroll
        for (int j = 4; j < 16; j += 4) { ma = __builtin_fmaxf(__builtin_fmaxf(ma, p0[j]), p0[j + 1]); mb = __builtin_fmaxf(__builtin_fmaxf(mb, p0[j + 2]), p0[j + 3]);
            ma = __builtin_fmaxf(__builtin_fmaxf(ma, p1[j]), p1[j + 1]); mb = __builtin_fmaxf(__builtin_fmaxf(mb, p1[j + 2]), p1[j + 3]); }
        float mx = __builtin_fmaxf(ma, mb);
        { auto rr_ = __builtin_amdgcn_permlane32_swap(__float_as_uint(mx), __float_as_uint(mx), false, false); mx = fmaxf(__uint_as_float(rr_[0]), __uint_as_float(rr_[1])); }
        if (t == 0 || __any(mx > 6.0f)) {
            const float dl = (t == 0) ? mx : __builtin_fmaxf(mx, 0.f);
            mrun += dl;
#pragma unroll
            for (int j = 0; j < 16; ++j) { p0[j] -= dl; p1[j] -= dl; }
            if (t > 0) { const float f = fexp2(-dl); lsum *= f;
#pragma unroll
                for (int b = 0; b < DV / 32; ++b)
#pragma unroll
                    for (int j = 0; j < 16; ++j) o[b][j] *= f; }
#pragma unroll
            for (int j = 0; j < 16; ++j) negm[j] = -mrun;
        }
        f32x2_t sa = {0.f, 0.f}, sb = {0.f, 0.f};
#pragma unroll
        for (int j = 0; j < 16; j += 2) { p0[j] = fexp2(p0[j]); p0[j + 1] = fexp2(p0[j + 1]); p1[j] = fexp2(p1[j]); p1[j + 1] = fexp2(p1[j + 1]);
            sa += (f32x2_t){p0[j], p0[j + 1]}; sb += (f32x2_t){p1[j], p1[j + 1]}; }
        sa += sb; lsum += sa[0] + sa[1];
        bf16x8 pf[2][2];
#pragma unroll
        for (int s = 0; s < 2; ++s) {
            u32x4 w0, w1;
            w0.x = pk2(p0[8 * s + 0], p0[8 * s + 1]); w0.y = pk2(p0[8 * s + 2], p0[8 * s + 3]); w0.z = pk2(p0[8 * s + 4], p0[8 * s + 5]); w0.w = pk2(p0[8 * s + 6], p0[8 * s + 7]);
            w1.x = pk2(p1[8 * s + 0], p1[8 * s + 1]); w1.y = pk2(p1[8 * s + 2], p1[8 * s + 3]); w1.z = pk2(p1[8 * s + 4], p1[8 * s + 5]); w1.w = pk2(p1[8 * s + 6], p1[8 * s + 7]);
            pf[0][s] = __builtin_bit_cast(bf16x8, w0); pf[1][s] = __builtin_bit_cast(bf16x8, w1);
        }
#pragma unroll
        for (int b = 0; b < DV / 32; ++b) {
            const LAS bf16_t* vp = Vt + (vrow + 32 * b + r32) * VS + 8 * hi;
#pragma unroll
            for (int kh = 0; kh < 2; ++kh)
#pragma unroll
                for (int s = 0; s < 2; ++s) {
                    const bf16x8 va = *(const LAS bf16x8*)(vp + 32 * kh + 16 * s);
                    o[b] = MFMA32(va, pf[kh][s], o[b]);
                }
        }
        __syncthreads();
    }
#undef A_GLOAD
#undef A_LSTORE
}

__device__ __forceinline__ void attn_store64(const f32x16 (&o)[2], float lsum, const bf16_t* gate, bf16_t* yout, int hi) {
    const float l = lsum + __shfl_xor(lsum, 32); const float inv = __builtin_amdgcn_rcpf(l);
    u32x2 gt[2][4];
#pragma unroll
    for (int b = 0; b < 2; ++b)
#pragma unroll
        for (int g = 0; g < 4; ++g) gt[b][g] = *(const u32x2*)(gate + 32 * b + 8 * g + 4 * hi);
#pragma unroll
    for (int b = 0; b < 2; ++b)
#pragma unroll
        for (int g = 0; g < 4; ++g) { const int dv = 32 * b + 8 * g + 4 * hi; const u32x2 q = gt[b][g];
            u32x2 w; w.x = pk2(o[b][4 * g] * inv * siluf_(bflo(q.x)), o[b][4 * g + 1] * inv * siluf_(bfhi(q.x)));
            w.y = pk2(o[b][4 * g + 2] * inv * siluf_(bflo(q.y)), o[b][4 * g + 3] * inv * siluf_(bfhi(q.y)));
            *(u32x2*)(yout + dv) = w; }
}

__device__ __forceinline__ void diff_unit(LAS unsigned char* lds, const bf16_t* ACT, bf16_t* YCAT, const KVSrc& S, int nT, size_t tok0, int h,
                                          float lam, float lam_init, const float* subln) {
    const int tid = ltid(), wid = __builtin_amdgcn_readfirstlane(tid >> 6), lane = tid & 63, r32 = lane & 31, hi = lane >> 5;
    const int map = wid >> 2, qs = wid & 3;
    const size_t tok = tok0 + qs * 32 + r32;
    f32x16 o[4]; float lsum;
    attn_core<128, 128, 0>(lds, ACT + tok * LDACT + A_DQ + h * 128 + map * 64, S, nT, map * 64, 0, nullptr, 0, 0, o, lsum);
    const float l = lsum + __shfl_xor(lsum, 32); const float inv = __builtin_amdgcn_rcpf(l);
    LAS float* X = (LAS float*)lds;
    if (map == 1) {
#pragma unroll
        for (int b = 0; b < 4; ++b)
#pragma unroll
            for (int j = 0; j < 16; ++j) X[((qs * 64) + b * 16 + j) * 64 + lane] = o[b][j] * inv;
    }
    __syncthreads();
    if (map == 0) {
        float ssq = 0.f;
#pragma unroll
        for (int b = 0; b < 4; ++b)
#pragma unroll
            for (int j = 0; j < 16; ++j) { const float d = o[b][j] * inv - lam * X[((qs * 64) + b * 16 + j) * 64 + lane]; o[b][j] = d; ssq += d * d; }
        ssq += __shfl_xor(ssq, 32);
        const float rs = rsqrtf(ssq * (1.0f / 128.0f) + EPSN) * (1.0f - lam_init);
        const bf16_t* gate = ACT + tok * LDACT + A_DG + h * 128;
        bf16_t* yout = YCAT + tok * LDY + Y_D + h * 128;
        u32x2 gt[4][4];
#pragma unroll
        for (int b = 0; b < 4; ++b)
#pragma unroll
            for (int g = 0; g < 4; ++g) gt[b][g] = *(const u32x2*)(gate + 32 * b + 8 * g + 4 * hi);
#pragma unroll
        for (int b = 0; b < 4; ++b)
#pragma unroll
            for (int g = 0; g < 4; ++g) { const int dv = 32 * b + 8 * g + 4 * hi;
                const u32x2 q = gt[b][g]; const f32x4 sg = *(const f32x4*)(subln + dv);
                u32x2 w; w.x = pk2(o[b][4 * g] * rs * sg[0] * siluf_(bflo(q.x)), o[b][4 * g + 1] * rs * sg[1] * siluf_(bfhi(q.x)));
                w.y = pk2(o[b][4 * g + 2] * rs * sg[2] * siluf_(bflo(q.y)), o[b][4 * g + 3] * rs * sg[3] * siluf_(bfhi(q.y)));
                *(u32x2*)(yout + dv) = w; }
    }
    __syncthreads();
}

__device__ __forceinline__ void spatial_unit(LAS unsigned char* lds, int chunk, const bf16_t* ACT, const bf16_t* SGVT, const bf16_t* SGW,
                                             const float* sgb, const float* sgng, bf16_t* YCAT) {
    const int tid = ltid(), wid = __builtin_amdgcn_readfirstlane(tid >> 6), lane = tid & 63, r32 = lane & 31, hi = lane >> 5;
    LAS float* part = (LAS float*)lds;
    LAS float* rr = part + 512;
    const size_t t0 = (size_t)chunk * 128;
    { const int tk = tid & 127, cq = tid >> 7; float s = 0.f;
#pragma unroll 16
      for (int c = cq * 128; c < cq * 128 + 128; ++c) { const float v = bf2f(SGVT[(size_t)c * TOK + t0 + tk]); s += v * v; }
      part[cq * 128 + tk] = s; }
    __syncthreads();
    if (tid < 128) rr[tid] = rsqrtf((part[tid] + part[128 + tid] + part[256 + tid] + part[384 + tid]) * (1.0f / 512.0f) + EPSN);
    __syncthreads();
    const int g = wid;
    const bf16_t* Wg = SGW + (size_t)g * 128 * 128;
#pragma unroll 1
    for (int cb = 0; cb < 2; ++cb) {
        bf16x8 vb[8];
        const unsigned c = g * 64 + cb * 32 + r32;
#pragma unroll
        for (int s = 0; s < 8; ++s) {
            const f32x4 r0 = *(const LAS f32x4*)(rr + 16 * s + 8 * hi), r1 = *(const LAS f32x4*)(rr + 16 * s + 8 * hi + 4);
            const u32x4 raw = *(const u32x4*)(SGVT + (size_t)c * TOK + t0 + 16 * s + 8 * hi);
            u32x4 w; w.x = pk2(bflo(raw.x) * r0[0], bfhi(raw.x) * r0[1]); w.y = pk2(bflo(raw.y) * r0[2], bfhi(raw.y) * r0[3]);
            w.z = pk2(bflo(raw.z) * r1[0], bfhi(raw.z) * r1[1]); w.w = pk2(bflo(raw.w) * r1[2], bfhi(raw.w) * r1[3]);
            vb[s] = __builtin_bit_cast(bf16x8, w);
        }
        const float gn = sgng[c];
#pragma unroll 1
        for (int pb = 0; pb < 4; ++pb) {
            f32x16 a0;
#pragma unroll
            for (int j = 0; j < 16; ++j) a0[j] = 0.f;
#pragma unroll
            for (int s = 0; s < 8; ++s) {
                const bf16x8 wa = *(const bf16x8*)(Wg + (unsigned)((pb * 32 + r32) * 128 + 16 * s + 8 * hi));
                a0 = MFMA32(wa, vb[s], a0);
            }
            unsigned short uu[16], gg[16]; float bb[16];
#pragma unroll
            for (int j = 0; j < 16; ++j) { const int p = pb * 32 + crow(j, hi); const unsigned tok = (unsigned)t0 + p;
                uu[j] = ACT[tok * (unsigned)LDACT + A_SGU + c]; gg[j] = ACT[tok * (unsigned)LDACT + A_SGG + c]; bb[j] = sgb[g * 128 + p]; }
#pragma unroll
            for (int j = 0; j < 16; ++j) { const int p = pb * 32 + crow(j, hi); const unsigned tok = (unsigned)t0 + p;
                const float sv = a0[j] * gn + bb[j];
                YCAT[tok * (unsigned)LDY + Y_SG + c] = (bf16_t)f2bf(bf2f(uu[j]) * sv * siluf_(bf2f(gg[j]))); }
        }
    }
    __syncthreads();
}

__device__ __forceinline__ void transpose_item(const float* W, int K, int N, bf16_t* WT, int ldt, int item, int lane, LAS float* scr, bool permute) {
    const int nblk = N / 32, kb = item / nblk, nb = item % nblk, k0 = 64 * kb, n0 = 32 * nb;
#pragma unroll 8
    for (int i = 0; i < 32; ++i) { const int kk = 2 * i + (lane >> 5); scr[kk * 33 + (lane & 31)] = W[(size_t)(k0 + kk) * N + n0 + (lane & 31)]; }
    asm volatile("s_waitcnt lgkmcnt(0)" ::: "memory");
    int d0 = n0;
    if (permute) { const int s = n0 >> 9; int ds;
        if (s == 1) ds = 18; else if (s == 5) ds = 19; else if (s == 9) ds = 20; else ds = s - (s > 9 ? 3 : s > 5 ? 2 : s > 1 ? 1 : 0);
        d0 = ds * 512 + (n0 & 511); }
    const int c = lane & 7;
#pragma unroll
    for (int j = 0; j < 4; ++j) { const int n = (lane >> 3) + 8 * j; const LAS float* s = scr + (8 * c) * 33 + n;
        u32x4 o; o.x = pk2(s[0 * 33], s[1 * 33]); o.y = pk2(s[2 * 33], s[3 * 33]); o.z = pk2(s[4 * 33], s[5 * 33]); o.w = pk2(s[6 * 33], s[7 * 33]);
        *(u32x4*)(WT + (size_t)(d0 + n) * ldt + k0 + 8 * c) = o; }
    asm volatile("s_waitcnt lgkmcnt(0)" ::: "memory");
}

__device__ __forceinline__ void convert_layer_weights(int l, LAS unsigned char* lds) {
    KPARAMS;
    const int tid = ltid(), wave = tid >> 6, lane = tid & 63;
    LAS float* scr = (LAS float*)(lds + wave * 16384);
    const int gw = blockIdx.x * 8 + wave, NGW = gridDim.x * 8;
    unsigned char* ws_ = lws(P); bf16_t* WIN = (bf16_t*)(ws_ + WS_WIN); bf16_t* WP = (bf16_t*)(ws_ + WS_WP); bf16_t* WO = (bf16_t*)(ws_ + WS_WO);
    constexpr int I_IN = 16 * 336, I_P = 8 * 32, I_F = 16 * 32, I_O = 16 * 32, NIT = I_IN + 3 * I_P + I_F + I_O;
    for (int it = gw; it < NIT; it += NGW) {
        int r = it;
        if (r < I_IN) { transpose_item(P.in[I_WIN] + (size_t)l * 1024 * NIN, 1024, NIN, WIN, 1024, r, lane, scr, true); continue; } r -= I_IN;
        if (r < I_P) { transpose_item(P.in[I_PSG] + (size_t)l * 512 * 1024, 512, 1024, WP, LDY, r, lane, scr, false); continue; } r -= I_P;
        if (r < I_P) { transpose_item(P.in[I_PDIFF] + (size_t)l * 512 * 1024, 512, 1024, WP + 512, LDY, r, lane, scr, false); continue; } r -= I_P;
        if (r < I_P) { transpose_item(P.in[I_PNA] + (size_t)l * 512 * 1024, 512, 1024, WP + 1024, LDY, r, lane, scr, false); continue; } r -= I_P;
        if (r < I_F) { transpose_item(P.in[I_PFNET] + (size_t)l * 1024 * 1024, 1024, 1024, WP + 1536, LDY, r, lane, scr, false); continue; } r -= I_F;
        transpose_item(P.in[I_WOUT] + (size_t)l * 1024 * 1024, 1024, 1024, WO, 1024, r, lane, scr, false);
    }
}

__device__ __forceinline__ void p1_rows(int l) {
    KPARAMS;
    const int tid = ltid(), wave = tid >> 6, lane = tid & 63;
    const int gw = blockIdx.x * 8 + wave, NGW = gridDim.x * 8;
    const float* MOD = (const float*)(P.ws + WS_MOD);
    const bf16_t* OUTRAW = (const bf16_t*)(P.ws + WS_ACT);
    bf16_t* HB = (bf16_t*)(P.ws + WS_R1);
#pragma unroll 1
    for (int t0 = gw; t0 < TOK; t0 += 2 * NGW) {
        f32x4 x[2][4]; u32x2 rq[2][4];
        int tt[2], cvv[2];
#pragma unroll
        for (int q = 0; q < 2; ++q) { int t = t0 + q * NGW; tt[q] = t; if (t >= TOK) t = t0; cvv[q] = t < TCTX ? 0 : 1 + ((t - TCTX) >> 12);
            const float* xs = (l <= 1) ? (t < TCTX ? P.in[I_XP] + (size_t)t * DM : P.in[I_XS] + (size_t)(t - TCTX) * DM) : P.out + (size_t)t * DM;
#pragma unroll
            for (int j = 0; j < 4; ++j) x[q][j] = *(const f32x4*)(xs + 4 * lane + 256 * j);
            if (l >= 1) {
#pragma unroll
                for (int j = 0; j < 4; ++j) rq[q][j] = *(const u32x2*)(OUTRAW + (size_t)t * DM + 4 * lane + 256 * j); } }
#pragma unroll
        for (int q = 0; q < 2; ++q) { const int t = tt[q], cv = cvv[q];
            if (t >= TOK) continue;
            if (l >= 1) {
                f32x4 r[4]; float s = 0.f;
#pragma unroll
                for (int j = 0; j < 4; ++j) { const u32x2 w = rq[q][j]; r[j] = (f32x4){bflo(w.x), bfhi(w.x), bflo(w.y), bfhi(w.y)}; s += r[j][0] * r[j][0] + r[j][1] * r[j][1] + r[j][2] * r[j][2] + r[j][3] * r[j][3]; }
                const float rs = rsqrtf(wave_sum(s) * (1.0f / DM) + EPSN);
                const float* gate = MOD + ((size_t)(l - 1) * 3 + cv) * 3072 + 2048;
                const float* gp = P.in[I_GPOST] + (size_t)(l - 1) * DM;
#pragma unroll
                for (int j = 0; j < 4; ++j) { const f32x4 gt = *(const f32x4*)(gate + 4 * lane + 256 * j), gg = *(const f32x4*)(gp + 4 * lane + 256 * j);
                    x[q][j] = x[q][j] + gt * (r[j] * rs * gg);
                    *(f32x4*)(P.out + (size_t)t * DM + 4 * lane + 256 * j) = x[q][j]; }
            }
            if (l < 4) {
                float s = 0.f;
#pragma unroll
                for (int j = 0; j < 4; ++j) s += x[q][j][0] * x[q][j][0] + x[q][j][1] * x[q][j][1] + x[q][j][2] * x[q][j][2] + x[q][j][3] * x[q][j][3];
                const float rs = rsqrtf(wave_sum(s) * (1.0f / DM) + EPSN);
                const float* md = MOD + ((size_t)l * 3 + cv) * 3072;
                const float* gp = P.in[I_GPRE] + (size_t)l * DM;
#pragma unroll
                for (int j = 0; j < 4; ++j) { const int c = 4 * lane + 256 * j;
                    const f32x4 sh = *(const f32x4*)(md + c), sc = *(const f32x4*)(md + 1024 + c), gg = *(const f32x4*)(gp + c);
                    const f32x4 hh = x[q][j] * rs * gg * (sc + 1.0f) + sh;
                    u32x2 w; w.x = pk2(hh[0], hh[1]); w.y = pk2(hh[2], hh[3]);
                    *(u32x2*)(HB + (size_t)t * DM + c) = w; }
            }
        }
    }
}

__device__ __forceinline__ void prologue(LAS unsigned char* lds) {
    KPARAMS;
    const int tid = ltid(), wave = tid >> 6, lane = tid & 63;
    const size_t gt = (size_t)blockIdx.x * NTHR + tid, GT = (size_t)gridDim.x * NTHR;
    LAS float* tab = (LAS float*)lds;
    for (int k = tid; k < 4096; k += NTHR) tab[k] = cosf((float)k * (6.283185307179586f / 4096.0f)) * (1.0f / 64.0f);
    __syncthreads();
    {
        bf16_t* CSL = (bf16_t*)(P.ws + WS_CSL);
        for (size_t e = gt; e < (size_t)4096 * 512; e += GT) { const int i = (int)(e >> 9), j0 = (int)(e & 511) * 8;
            u32x4 wc, ws; unsigned* pc = (unsigned*)&wc; unsigned* ps = (unsigned*)&ws;
#pragma unroll
            for (int q = 0; q < 4; ++q) { const int i0 = (i * (j0 + 2 * q)) & 4095, i1 = (i * (j0 + 2 * q + 1)) & 4095;
                pc[q] = pk2(tab[i0], tab[i1]); ps[q] = pk2(tab[(i0 + 1024) & 4095], tab[(i1 + 1024) & 4095]); }
            *(u32x4*)(CSL + (size_t)i * 8192 + j0) = wc; *(u32x4*)(CSL + (size_t)i * 8192 + 4096 + j0) = ws; }
        bf16_t* CS256 = (bf16_t*)(P.ws + WS_CS256); bf16_t* CSP = (bf16_t*)(P.ws + WS_CSP256);
        for (size_t e = gt; e < 256 * 256; e += GT) { const int j = (int)(e >> 8), k = (int)(e & 255); const int idx = ((j * k) & 255) * 16;
            const float cv = tab[idx] * 4.0f, sv = tab[(idx + 3072) & 4095] * 4.0f;
            CS256[j * 256 + k] = (bf16_t)f2bf(cv); CS256[(256 + j) * 256 + k] = (bf16_t)f2bf(sv);
            CSP[j * 512 + k] = (bf16_t)f2bf(cv); CSP[j * 512 + 256 + k] = (bf16_t)f2bf(-sv); }
    }
    {
        float* ROPE = (float*)(P.ws + WS_ROPE);
        for (size_t e = gt; e < 64 * 16; e += GT) { const int pos = (int)(e >> 4), f = (int)(e & 15);
            const float inv = powf(10000.0f, -(float)f / 16.0f); const float ang = (float)pos * inv;
            ROPE[pos * 32 + f] = cosf(ang); ROPE[pos * 32 + 16 + f] = sinf(ang); }
        float* RPB = (float*)(P.ws + WS_RPB);
        for (size_t e = gt; e < 4 * 8 * 15 * 31; e += GT) RPB[e] = P.in[I_RPB][e] * LOG2E;
        bf16_t* SGW = (bf16_t*)(P.ws + WS_SGW);
        for (size_t e = gt; e < 4 * 8 * 128 * 128; e += GT) SGW[e] = (bf16_t)f2bf(P.in[I_SGW][e]);
    }
    {
        bf16_t* CDK = (bf16_t*)(P.ws + WS_CDK); bf16_t* CNK = (bf16_t*)(P.ws + WS_CNK);
        bf16_t* CDVT = (bf16_t*)(P.ws + WS_CDVT); bf16_t* CNVT = (bf16_t*)(P.ws + WS_CNVT);
        const size_t NC4 = (size_t)2 * 4 * 512 * 512 / 4;
        for (size_t e = gt; e < NC4; e += GT) { const f32x4 a = *(const f32x4*)(P.in[I_CDK] + 4 * e), b = *(const f32x4*)(P.in[I_CNK] + 4 * e);
            u32x2 wa, wb; wa.x = pk2(a[0], a[1]); wa.y = pk2(a[2], a[3]); wb.x = pk2(b[0], b[1]); wb.y = pk2(b[2], b[3]);
            *(u32x2*)(CDK + 4 * e) = wa; *(u32x2*)(CNK + 4 * e) = wb; }
        LAS float* tl = (LAS float*)(lds + 32768);
        const int ti = tid >> 6, tj = tid & 63;
        for (int tile = blockIdx.x; tile < 1024; tile += gridDim.x) {
            const int arr = tile >> 9, r = tile & 511, bl = r >> 6, pb = (r >> 3) & 7, fb = r & 7;
            const float* src = (arr ? P.in[I_CNV] : P.in[I_CDV]) + ((size_t)(bl * 512 + pb * 64) * 512 + fb * 64);
#pragma unroll
            for (int rr = 0; rr < 8; ++rr) { const int p = rr * 8 + ti; tl[p * 65 + tj] = src[(size_t)p * 512 + tj]; }
            __syncthreads();
            bf16_t* dst = (arr ? CNVT : CDVT) + ((size_t)(bl * 512 + fb * 64) * 512 + pb * 64);
#pragma unroll
            for (int rr = 0; rr < 8; ++rr) { const int f = rr * 8 + ti; dst[(size_t)f * 512 + tj] = (bf16_t)f2bf(tl[tj * 65 + f]); }
            __syncthreads();
        }
    }
    __syncthreads();
    {
        float* MOD = (float*)(P.ws + WS_MOD);
        LAS float* red = (LAS float*)lds;
        LAS float* sc = (LAS float*)(lds + 16384);
        for (int k = tid; k < 1024; k += NTHR) { sc[k] = siluf_(P.in[I_CCTX][k]); sc[1024 + k] = siluf_(P.in[I_C][k]); sc[2048 + k] = siluf_(P.in[I_C][1024 + k]); }
        __syncthreads();
        for (int un = blockIdx.x; un < 4 * 48; un += gridDim.x) {
            const int l = un / 48, jb = un % 48; const int j = jb * 64 + lane;
            const float* w = P.in[I_WMOD] + (size_t)l * 1024 * 3072 + j;
            float a0 = 0.f, a1 = 0.f, a2 = 0.f;
#pragma unroll 1
            for (int k0 = wave * 128; k0 < wave * 128 + 128; k0 += 16) {
                float wv[16];
#pragma unroll
                for (int i = 0; i < 16; ++i) wv[i] = w[(size_t)(k0 + i) * 3072];
#pragma unroll
                for (int i = 0; i < 16; ++i) { a0 += sc[k0 + i] * wv[i]; a1 += sc[1024 + k0 + i] * wv[i]; a2 += sc[2048 + k0 + i] * wv[i]; }
            }
            red[(wave * 3 + 0) * 64 + lane] = a0; red[(wave * 3 + 1) * 64 + lane] = a1; red[(wave * 3 + 2) * 64 + lane] = a2;
            __syncthreads();
            if (tid < 192) { const int cv = tid >> 6, ln = tid & 63; float sm = 0.f;
#pragma unroll
                for (int w8 = 0; w8 < 8; ++w8) sm += red[(w8 * 3 + cv) * 64 + ln];
                MOD[((size_t)l * 3 + cv) * 3072 + jb * 64 + ln] = sm + P.in[I_BMOD][(size_t)l * 3072 + jb * 64 + ln]; }
            __syncthreads();
        }
    }
}

__device__ __forceinline__ void combine_pf() {
    KPARAMS;
    const float* PF = (const float*)(P.ws + WS_R1); const bf16_t* ACT = (const bf16_t*)(P.ws + WS_ACT); bf16_t* YCAT = (bf16_t*)(P.ws + WS_YCAT);
    const size_t gt = (size_t)blockIdx.x * NTHR + ltid(), GT = (size_t)gridDim.x * NTHR;
    for (size_t e = gt; e < (size_t)8192 * 256; e += GT) { const size_t t = e >> 8; const int c = (int)(e & 255) * 4;
        const f32x4 a = *(const f32x4*)(PF + t * 1024 + c), b = *(const f32x4*)(PF + (size_t)8192 * 1024 + t * 1024 + c);
        const size_t tok = TCTX + t;
        const u32x2 g = *(const u32x2*)(ACT + tok * LDACT + A_FG + c);
        u32x2 w; w.x = pk2((a[0] + b[0]) * bflo(g.x), (a[1] + b[1]) * bfhi(g.x)); w.y = pk2((a[2] + b[2]) * bflo(g.y), (a[3] + b[3]) * bfhi(g.y));
        *(u32x2*)(YCAT + tok * LDY + Y_F + c) = w; }
}

constexpr size_t WS_BAR = WS_SMALL + 2 * MiB + 512 * 1024;
constexpr int LDS_BARST = LDS_BYTES - 64;
#define XB_TMO      128
#define XB_XCNT(j)  (256  + 64 * (j))
#define XB_XSUB(j)  (1280 + 64 * (j))
#define XB_XGEN(j)  (2304 + 64 * (j))
#define XB_TOP      3328
#define XB_TOPGEN   3392
#define XCD_BAR_WORDS 3456
#define XB_SPIN_CAP (1u << 20)
__device__ __forceinline__ unsigned xb_ld(unsigned* p)              { return __hip_atomic_load(p, __ATOMIC_RELAXED, __HIP_MEMORY_SCOPE_AGENT); }
__device__ __forceinline__ unsigned xb_add(unsigned* p, unsigned v) { return __hip_atomic_fetch_add(p, v, __ATOMIC_RELAXED, __HIP_MEMORY_SCOPE_AGENT); }
__device__ __forceinline__ unsigned xb_xcc_id() { return (unsigned)__builtin_amdgcn_s_getreg((3 << 11) | 20) & 0xFu; }
#define XB_SPIN(cond, bar) do { unsigned _sp = 0; while (cond) { __builtin_amdgcn_s_sleep(1); \
    if ((++_sp & 255u) == 0u) { if (xb_ld(&(bar)[XB_TMO])) break; if (_sp > XB_SPIN_CAP) { atomicAdd(&(bar)[XB_TMO], 1u); break; } } } } while (0)
__device__ __forceinline__ void xcd_barrier_complete(unsigned* bar, unsigned x, unsigned& nloc, unsigned& nx) {
    const unsigned G = gridDim.x;
    unsigned sum, cnt, mine, sp = 0u;
    for (;;) {
        sum = 0u; cnt = 0u; mine = 0u;
#pragma unroll
        for (unsigned j = 0; j < 16; ++j) { const unsigned c = xb_ld(&bar[XB_XCNT(j)]); sum += c; cnt += (c > 0u) ? 1u : 0u; mine = (j == x) ? c : mine; }
        if (sum == G) break;
        __builtin_amdgcn_s_sleep(1);
        if ((++sp & 255u) == 0u) { if (xb_ld(&bar[XB_TMO])) break; if (sp > XB_SPIN_CAP) { atomicAdd(&bar[XB_TMO], 1u); break; } }
    }
    nloc = mine > 0u ? mine : 1u; nx = cnt > 0u ? cnt : 1u;
}
__device__ __forceinline__ void gbar(LAS unsigned char* lds) {
    KPARAMS;
    asm volatile("s_waitcnt vmcnt(0)" ::: "memory");
    __syncthreads();
    if (threadIdx.x == 0) {
        unsigned* bar = (unsigned*)(lws(P) + WS_BAR);
        volatile LAS unsigned* st = (volatile LAS unsigned*)(lds + LDS_BARST);
        const unsigned x = xb_xcc_id();
        __builtin_amdgcn_s_waitcnt(0);
        unsigned nloc = st[0], nx = st[1];
        if (nloc == 0u) { xcd_barrier_complete(bar, x, nloc, nx); st[0] = nloc; st[1] = nx; }
        const unsigned old = xb_add(&bar[XB_XSUB(x)], 1u);
        const unsigned gen = old / nloc;
        if (old + 1u == (gen + 1u) * nloc) {
            __builtin_amdgcn_fence(__ATOMIC_RELEASE, "agent");
            asm volatile("s_waitcnt vmcnt(0)" ::: "memory");
            const unsigned og = xb_add(&bar[XB_TOP], 1u);
            const unsigned tg = og / nx;
            if (og + 1u == (tg + 1u) * nx) xb_add(&bar[XB_TOPGEN], 1u);
            else XB_SPIN(xb_ld(&bar[XB_TOPGEN]) == tg, bar);
            __builtin_amdgcn_fence(__ATOMIC_ACQUIRE, "agent");
            xb_add(&bar[XB_XGEN(x)], 1u);
            asm volatile("s_waitcnt vmcnt(0)" ::: "memory");
        } else {
            XB_SPIN(xb_ld(&bar[XB_XGEN(x)]) == gen, bar);
            __builtin_amdgcn_fence(__ATOMIC_ACQUIRE, "agent");
            asm volatile("s_waitcnt vmcnt(0)" ::: "memory");
        }
    }
    __syncthreads();
}

#ifndef REP_P2
#define REP_P2 1
#endif
#ifndef REP_DFT
#define REP_DFT 1
#endif
#ifndef REP_DL
#define REP_DL 1
#endif
#ifndef REP_AR
#define REP_AR 1
#endif
#ifndef REP_P4
#define REP_P4 1
#endif
#ifndef REP_P5
#define REP_P5 1
#endif
#ifndef REP_CONV
#define REP_CONV 1
#endif

struct EpiC { static constexpr bool HOOK = false; EpiCdft e; __device__ __forceinline__ void operator()(EPI_ARGS) const { Unit v = u; v.pm = u.x * 2 + u.pm; e(acc, v, wr, wc, fr, fq); } };
__device__ __forceinline__ void phase2(int l, LAS unsigned char* lds) {
    KPARAMS;
    unsigned char* ws = lws(P); const int G = gridDim.x, bid = lbid();
    bf16_t* WIN = (bf16_t*)(ws + WS_WIN); bf16_t* HB = (bf16_t*)(ws + WS_R1); bf16_t* ACT = (bf16_t*)(ws + WS_ACT); bf16_t* XT = (bf16_t*)(ws + WS_R3);
#pragma unroll 1
    for (int step = 0; step < 3; ++step) {
        const int which = (bid >= (G >> 1)) ? (step == 0 ? 2 : step - 1) : step;
        if (which == 0) {
            Job J{HB, WIN, 1024, 1024, 1024, 64, 36, 1, G, bid, 256L * 1024, 0, 0, 0, 256L * 1024, 0, 1};
            EpiIn E{ACT, P.out + (size_t)1 * 16777216, P.out + (size_t)3 * 16777216, (const float*)(ws + WS_ROPE), l};
            pg8::gemm_phase(lds, J, E);
        } else if (which == 1) {
            Job J{WIN + (size_t)9216 * 1024, HB, 1024, 1024, 1024, 6, 64, 1, G, bid, 256L * 1024, 0, 0, 0, 256L * 1024, 0, 0};
            EpiInT E{XT, P.out + (size_t)2 * 16777216, P.out + (size_t)4 * 16777216, l};
            pg8::gemm_phase(lds, J, E);
        } else {
            const int hG = G >> 1;
            if (bid >= hG) {
            Job J{(const bf16_t*)(ws + WS_CS256), HB, 256, 1024, 256, 2, 64, 4, hG, bid - hG, 256L * 256, 0, 0, 0, 256L * 1024, 256, 0};
            EpiC E{{(bf16_t*)(ws + WS_R2), (bf16_t*)(ws + WS_R2 + 32 * MiB)}};
            pg8::gemm_phase(lds, J, E);
            }
        }
    }
}

__device__ __forceinline__ void phase3_dft(int l, LAS unsigned char* lds) {
    KPARAMS;
    unsigned char* ws = lws(P); const int G = gridDim.x, bid = lbid(), hG = G >> 1;
    if (bid < hG) {
        Job J{(const bf16_t*)(ws + WS_CSL), (const bf16_t*)(ws + WS_R2 + 32 * MiB), 8192, 8192, 8192, 16, 4, 2, hG, bid, 256L * 8192, 0, 0, 0, 256L * 8192, 1024L * 8192, 0};
        EpiPdftCtx E{(const bf16_t*)(ws + WS_ACT), (bf16_t*)(ws + WS_YCAT), TCTX, 4096};
        pg8::gemm_phase(lds, J, E);
    } else {
        Job J{(const bf16_t*)(ws + WS_CSP256), (const bf16_t*)(ws + WS_R2), 512, 512, 512, 1, 4, 32, G - hG, bid - hG, 0, 0, 0, 0, 256L * 512, 1024L * 512, 0};
        EpiPdftCtx E{(const bf16_t*)(ws + WS_ACT), (bf16_t*)(ws + WS_YCAT), 0, 256};
        pg8::gemm_phase(lds, J, E);
    }
}

__device__ __forceinline__ void na_unit(int l, int id, LAS unsigned char* lds) {
    KPARAMS;
    unsigned char* ws = lws(P);
    const bf16_t* ACT = (const bf16_t*)(ws + WS_ACT); const bf16_t* XT = (const bf16_t*)(ws + WS_R3); bf16_t* YCAT = (bf16_t*)(ws + WS_YCAT);
    const int tid = ltid(), wid = __builtin_amdgcn_readfirstlane(tid >> 6), lane = tid & 63, r32 = lane & 31, hi = lane >> 5;
        const int xc = id & 7, jj = id >> 3, b = xc >> 2, hg = (xc >> 1) & 1, r = (xc & 1) * 32 + jj;
        const int r0 = min(max(r - 4, 0), 56);
        const size_t base = TCTX + (size_t)b * 4096;
        KVSrc S{ACT + (base + (size_t)r0 * 64) * LDACT + A_NK + hg * 256, LDACT, XT + (size_t)(1024 + hg * 256) * TOK + base + (size_t)r0 * 64, TOK, 8,
                (const bf16_t*)(ws + WS_CNK) + ((size_t)(b * 4 + l) * 512) * 512 + hg * 256, 512, (const bf16_t*)(ws + WS_CNVT) + ((size_t)(b * 4 + l) * 512 + hg * 256) * 512, 512};
        const int hl = wid >> 1, qh = wid & 1, h = hg * 4 + hl, qc = qh * 32 + r32;
        const size_t tok = base + (size_t)r * 64 + qc;
        f32x16 o[2]; float lsum;
        LAS float* rpbl = (LAS float*)(lds + 141312);
        { const float* rsrc = (const float*)(ws + WS_RPB) + (size_t)(l * 8 + hg * 4) * 15 * 31;
          for (int i = tid; i < 4 * 15 * 31; i += NTHR) rpbl[i] = rsrc[i]; }
        attn_core<64, 256, 2>(lds, ACT + tok * LDACT + A_NQ + h * 64, S, 16, hl * 64, hl * 64, rpbl + hl * 15 * 31, r0 - r, qc, o, lsum);
        attn_store64(o, lsum, ACT + tok * LDACT + A_NG + h * 64, YCAT + tok * LDY + Y_NA + h * 64, hi);
}

__device__ __forceinline__ void phase3_attn_a(int l, LAS unsigned char* lds) {
    KPARAMS;
    unsigned char* ws = lws(P); const int G = gridDim.x, bid = lbid();
    const bf16_t* ACT = (const bf16_t*)(ws + WS_ACT); const bf16_t* XT = (const bf16_t*)(ws + WS_R3); bf16_t* YCAT = (bf16_t*)(ws + WS_YCAT);
    const int tid = ltid(), wid = __builtin_amdgcn_readfirstlane(tid >> 6), lane = tid & 63, r32 = lane & 31, hi = lane >> 5;
    const float lam_init = 0.8f - 0.6f * expf(-0.3f * (float)l);
    const float d1 = wave_sum(P.in[I_LQ1][l * 64 + lane] * P.in[I_LK1][l * 64 + lane]);
    const float d2 = wave_sum(P.in[I_LQ2][l * 64 + lane] * P.in[I_LK2][l * 64 + lane]);
    const float lam = expf(d1) - expf(d2) + lam_init;
    const float* subln = P.in[I_SUBLN] + l * 128;
#pragma unroll 1
    for (int rp = 0; rp < REP_AR; ++rp) {
    if (bid >= (G >> 1)) {
#pragma unroll 1
        for (int id = bid - (G >> 1); id < 256; id += G - (G >> 1)) na_unit(l, id, lds);
    }
    for (int id = bid; id < 256; id += G) {
        const int b = id >> 3, h = (id >> 1) & 3, qh = id & 1;
        const size_t base = (size_t)b * 256;
        KVSrc S{ACT + base * LDACT + A_DK + h * 128, LDACT, XT + (size_t)(512 + h * 128) * TOK + base, TOK, 4, nullptr, 0, nullptr, 0};
        diff_unit(lds, ACT, YCAT, S, 4, base + (size_t)qh * 128, h, lam, lam_init, subln);
    }
    for (int id = bid; id < 256; id += G) {
        const int b = id >> 3, h = id & 7;
        const size_t base = (size_t)b * 256;
        KVSrc S{ACT + base * LDACT + A_NK + h * 64, LDACT, XT + (size_t)(1024 + h * 64) * TOK + base, TOK, 4, nullptr, 0, nullptr, 0};
        const size_t tok = base + wid * 32 + r32;
        f32x16 o[2]; float lsum;
        attn_core<64, 64, 0>(lds, ACT + tok * LDACT + A_NQ + h * 64, S, 4, 0, 0, nullptr, 0, 0, o, lsum);
        attn_store64(o, lsum, ACT + tok * LDACT + A_NG + h * 64, YCAT + tok * LDY + Y_NA + h * 64, hi);
    }
    for (int id = G - 1 - bid; id < 128; id += G)
        spatial_unit(lds, id, ACT, XT, (const bf16_t*)(ws + WS_SGW) + (size_t)l * 8 * 128 * 128, P.in[I_SGB] + l * 1024, P.in[I_SGNG] + l * 512, YCAT);
    }
}

__device__ __forceinline__ void phase3_attn_b(int l, LAS unsigned char* lds) {
    KPARAMS;
    unsigned char* ws = lws(P); const int G = gridDim.x, bid = lbid();
    const bf16_t* ACT = (const bf16_t*)(ws + WS_ACT); const bf16_t* XT = (const bf16_t*)(ws + WS_R3); bf16_t* YCAT = (bf16_t*)(ws + WS_YCAT);
    const int tid = ltid(), wid = __builtin_amdgcn_readfirstlane(tid >> 6), lane = tid & 63, r32 = lane & 31, hi = lane >> 5;
    const float lam_init = 0.8f - 0.6f * expf(-0.3f * (float)l);
    const float d1 = wave_sum(P.in[I_LQ1][l * 64 + lane] * P.in[I_LK1][l * 64 + lane]);
    const float d2 = wave_sum(P.in[I_LQ2][l * 64 + lane] * P.in[I_LK2][l * 64 + lane]);
    const float lam = expf(d1) - expf(d2) + lam_init;
    const float* subln = P.in[I_SUBLN] + l * 128;
#pragma unroll 1
    for (int rp = 0; rp < REP_DL; ++rp)
    for (int id = bid; id < 256; id += G) {
        const int bh = id & 7, qb = id >> 3, b = bh >> 2, h = bh & 3;
        const size_t base = TCTX + (size_t)b * 4096;
        KVSrc S{ACT + base * LDACT + A_DK + h * 128, LDACT, XT + (size_t)(512 + h * 128) * TOK + base, TOK, 64,
                (const bf16_t*)(ws + WS_CDK) + ((size_t)(b * 4 + l) * 512) * 512 + h * 128, 512, (const bf16_t*)(ws + WS_CDVT) + ((size_t)(b * 4 + l) * 512 + h * 128) * 512, 512};
        diff_unit(lds, ACT, YCAT, S, 72, base + (size_t)qb * 128, h, lam, lam_init, subln);
    }
}

__device__ __forceinline__ void phase_mix(LAS unsigned char* lds) {
    KPARAMS;
    unsigned char* ws = lws(P); const int G = gridDim.x, bid = lbid();
    Job J{(const bf16_t*)(ws + WS_YCAT), (const bf16_t*)(ws + WS_WP), LDY, LDY, LDY, 64, 4, 1, G, bid, 256L * LDY, 0, 0, 0, 256L * LDY, 0, 1};
    EpiMix E{(const bf16_t*)(ws + WS_ACT), (bf16_t*)(ws + WS_R3)};
    pg8::gemm_phase(lds, J, E);
}

__device__ __forceinline__ void phase5(LAS unsigned char* lds) {
    KPARAMS;
    unsigned char* ws = lws(P); const int G = gridDim.x, bid = lbid();
    Job J{(const bf16_t*)(ws + WS_R3), (const bf16_t*)(ws + WS_WO), 1024, 1024, 1024, 64, 4, 1, G, bid, 256L * 1024, 0, 0, 0, 256L * 1024, 0, 1};
    EpiOut E{(bf16_t*)(ws + WS_ACT)};
    pg8::gemm_phase(lds, J, E);
}

__global__ void __launch_bounds__(NTHR, 2) fwd_megakernel(Params P) {
    extern __shared__ __attribute__((aligned(16))) unsigned char smem[];
    LAS unsigned char* lds = (LAS unsigned char*)smem;
    cg::grid_group grid = cg::this_grid();
    if (threadIdx.x < 16) ((LAS unsigned*)(lds + LDS_BARST))[threadIdx.x] = 0u;
    if (blockIdx.x == 0) { unsigned* bar = (unsigned*)(P.ws + WS_BAR); for (int i = threadIdx.x; i < XCD_BAR_WORDS; i += NTHR) __hip_atomic_store(bar + i, 0u, __ATOMIC_RELAXED, __HIP_MEMORY_SCOPE_AGENT); }
    prologue(lds);
    grid.sync();
    if (threadIdx.x == 0) (void)xb_add((unsigned*)(P.ws + WS_BAR) + XB_XCNT(xb_xcc_id()), 1u);
#pragma unroll 1
    for (int l = 0; l < 4; ++l) {
#pragma unroll 1
        for (int rp = 0; rp < REP_CONV; ++rp) convert_layer_weights(l, lds);
        p1_rows(l);
        gbar(lds);
#pragma unroll 1
        for (int rp = 0; rp < REP_P2; ++rp) phase2(l, lds);
        gbar(lds);
#pragma unroll 1
        for (int rp = 0; rp < REP_DFT; ++rp) phase3_dft(l, lds);
        phase3_attn_a(l, lds);
        phase3_attn_b(l, lds);
        gbar(lds);
#pragma unroll 1
        for (int rp = 0; rp < REP_P4; ++rp) {
        if (rp) gbar(lds);
        phase_mix(lds);
        gbar(lds);
        }
#pragma unroll 1
        for (int rp = 0; rp < REP_P5; ++rp) phase5(lds);
        gbar(lds);
    }
    p1_rows(4);
}

extern "C" void kernel_launch(void* const* d_in, const int* in_sizes, int n_in, void* d_out, int out_size, void* d_ws, size_t ws_size, hipStream_t stream) {
    static int grid = 0;
    if (grid == 0) {
        if (n_in != 27 || ws_size < WS_END) { fprintf(stderr, "kernel_launch: unexpected n_in %d or ws_size %zu (< %zu)\n", n_in, ws_size, (size_t)WS_END); grid = -1; return; }
        int dev = 0, cus = 0, per_cu = 0;
        hipGetDevice(&dev);
        hipDeviceGetAttribute(&cus, hipDeviceAttributeMultiprocessorCount, dev);
        hipFuncSetAttribute((const void*)fwd_megakernel, hipFuncAttributeMaxDynamicSharedMemorySize, LDS_BYTES);
        hipOccupancyMaxActiveBlocksPerMultiprocessor(&per_cu, (const void*)fwd_megakernel, NTHR, LDS_BYTES);
        if (per_cu < 1) { fprintf(stderr, "kernel_launch: occupancy query says %d blocks/CU\n", per_cu); per_cu = 1; }
        (void)hipGetLastError();
        grid = cus;
    }
    if (grid < 0) return;
    Params p{};
    for (int i = 0; i < 27; ++i) p.in[i] = (const float*)d_in[i];
    p.out = (float*)d_out; p.ws = (unsigned char*)d_ws;
    void* args[] = {&p};
    hipError_t e = hipLaunchCooperativeKernel((const void*)fwd_megakernel, dim3(grid), dim3(NTHR), args, LDS_BYTES, stream);
    if (e != hipSuccess) fprintf(stderr, "cooperative launch failed: %s (grid %d)\n", hipGetErrorString(e), grid);
}
```

```cpp
#include <hip/hip_runtime.h>
#include <hip/hip_cooperative_groups.h>
#include <cstdio>
#include <cstdint>
namespace cg = cooperative_groups;

#define LAS __attribute__((address_space(3)))
typedef unsigned short bf16_t;
typedef short bf16x8 __attribute__((ext_vector_type(8)));
typedef short s16x4 __attribute__((ext_vector_type(4)));
typedef float f32x4 __attribute__((ext_vector_type(4)));
typedef float f32x16 __attribute__((ext_vector_type(16)));
typedef unsigned u32x4 __attribute__((ext_vector_type(4)));
typedef unsigned u32x2 __attribute__((ext_vector_type(2)));

constexpr int DM = 1024, TOK = 16384, TCTX = 8192, NIN = 10752, LDACT = 4160, LDY = 2560;
constexpr int GF_TILES = 20, GF_TILE = 65536;
constexpr int A_SGU = 0, A_SGG = 512, A_DQ = 1024, A_DK = 1536, A_DG = 2048, A_NQ = 2560, A_NK = 3072, A_NG = 3584, A_FG = 4096, A_MG = 5120;
constexpr int Y_SG = 0, Y_D = 512, Y_NA = 1024, Y_F = 1536;
constexpr float EPSN = 1e-6f;
constexpr float QSCALE = 0.125f * 1.4426950408889634f;
constexpr float LOG2E = 1.4426950408889634f;
constexpr int NTHR = 512;
constexpr int LDS_BYTES = 155648;

constexpr size_t MiB = 1u << 20;
constexpr size_t WS_WIN = 0;
constexpr size_t WS_WP = 21 * MiB;
constexpr size_t WS_WO = 26 * MiB;
constexpr size_t WS_CSL = 28 * MiB;
constexpr size_t WS_CDK = 92 * MiB, WS_CDVT = 96 * MiB, WS_CNK = 100 * MiB, WS_CNVT = 104 * MiB;
constexpr size_t WS_SMALL = 108 * MiB;
constexpr size_t WS_CS256 = WS_SMALL, WS_CSP256 = WS_SMALL + 256 * 1024, WS_ROPE = WS_SMALL + 512 * 1024, WS_RPB = WS_SMALL + 576 * 1024,
                 WS_MOD = WS_SMALL + 704 * 1024, WS_SGW = WS_SMALL + 1 * MiB;
constexpr size_t WS_ACT = 112 * MiB;
constexpr size_t WS_GF = WS_ACT + 132 * MiB;
constexpr size_t WS_R1 = 432 * MiB;
constexpr size_t WS_R2 = 464 * MiB;
constexpr size_t WS_R3 = 528 * MiB;
constexpr size_t WS_YCAT = 576 * MiB;
constexpr size_t WS_END = 656 * MiB;

struct Params {
    const float* in[27];
    float* out;
    unsigned char* ws;
};
typedef const __attribute__((address_space(4))) Params* KP;
enum { I_XP = 0, I_XS, I_CDK, I_CDV, I_CNK, I_CNV, I_C, I_CCTX, I_WMOD, I_BMOD, I_GPRE, I_GPOST, I_WIN, I_SGNG, I_SGW, I_SGB,
       I_LQ1, I_LK1, I_LQ2, I_LK2, I_SUBLN, I_RPB, I_PSG, I_PDIFF, I_PNA, I_PFNET, I_WOUT };

__device__ __forceinline__ unsigned f2bf(float f) { unsigned u = __builtin_bit_cast(unsigned, f); return (u + 0x7fffu + ((u >> 16) & 1u)) >> 16; }
typedef float f32x2_t __attribute__((ext_vector_type(2))); typedef __bf16 bf16x2_t __attribute__((ext_vector_type(2)));
__device__ __forceinline__ unsigned pk2(float lo, float hi) { f32x2_t v = {lo, hi}; bf16x2_t b = __builtin_convertvector(v, bf16x2_t); return __builtin_bit_cast(unsigned, b); }
__device__ __forceinline__ float bf2f(unsigned short b) { return __builtin_bit_cast(float, (unsigned)b << 16); }
__device__ __forceinline__ float bflo(unsigned w) { return __builtin_bit_cast(float, w << 16); }
__device__ __forceinline__ float bfhi(unsigned w) { return __builtin_bit_cast(float, w & 0xffff0000u); }
__device__ __forceinline__ float wave_sum(float v) {
#pragma unroll
    for (int o = 1; o < 64; o <<= 1) v += __shfl_xor(v, o);
    return v;
}
constexpr float LOG2E_ = 1.4426950408889634f;
__device__ __forceinline__ float fexp2(float x) { return __builtin_amdgcn_exp2f(x); }
__device__ __forceinline__ float sigmoidf_(float x) { return __builtin_amdgcn_rcpf(1.0f + __builtin_amdgcn_exp2f(-LOG2E_ * x)); }
__device__ __forceinline__ float einvsig_(float x) { return 1.0f + __builtin_amdgcn_exp2f(-LOG2E_ * x); }
__device__ __forceinline__ float siluf_(float x) { return x * __builtin_amdgcn_rcpf(1.0f + __builtin_amdgcn_exp2f(-LOG2E_ * x)); }
__device__ __forceinline__ int ltid() { int t = threadIdx.x; asm volatile("" : "+v"(t)); return t; }
#if defined(__HIP_DEVICE_COMPILE__)
__device__ __forceinline__ KP kparams() { KP p = (KP)__builtin_amdgcn_kernarg_segment_ptr(); asm volatile("" : "+s"(p)); return p; }
#endif
#if defined(__HIP_DEVICE_COMPILE__)
#define KPARAMS const KP PP = kparams(); const Params P = *PP
#else
#define KPARAMS const Params P{}
#endif
__device__ __forceinline__ unsigned char* lws(const Params& P) { unsigned char* w = P.ws; asm volatile("" : "+s"(w)); return w; }
__device__ __forceinline__ int lbid() { int b = blockIdx.x; asm volatile("" : "+s"(b)); return b; }
__device__ __forceinline__ unsigned gf_off(int wr, int wc, int ai, int m, int bj, int lane) { return (((((unsigned)(wr * 4 + wc) * 2 + ai) * 4 + m) * 2 + bj) * 64 + lane) * 8u; }
__device__ __forceinline__ int crow(int r, int hi) { return (r & 3) + 8 * (r >> 2) + 4 * hi; }

namespace pg8 {
constexpr int BM = 256, BK = 64, HALF = 128, HTB = HALF * BK * 2, STAGE_BYTES = 8 * HTB;
__device__ __forceinline__ int lds_byte(int r, int c) { const int st = (r >> 4) * 2 + (c >> 5), rr = r & 15, cc = c & 31, ob = rr * 64 + cc * 2; return st * 1024 + (ob ^ (((ob >> 9) & 1) << 5)); }
__device__ __forceinline__ int perm32(int rho) { const int n = rho >> 4, i = rho & 15; return 8 * (i >> 2) + 4 * n + (i & 3); }
__device__ __forceinline__ void stage_rc(int b, int& R, int& C) { const int st = b / 1024, sb = b % 1024, swz = sb ^ (((sb >> 9) & 1) << 5); R = (st >> 1) * 16 + swz / 64; C = (st & 1) * 32 + (swz % 64) / 2; }
struct Unit { int pm, pn, x; };

template <class Job, class Epi>
__device__ __forceinline__ void gemm_phase(LAS unsigned char* lds, const Job& J, const Epi& E) {
    const int tid = ltid(), wid = __builtin_amdgcn_readfirstlane(tid >> 6), lane = tid & 63, wr = wid >> 2, wc = wid & 3, fr = lane & 15, fq = lane >> 4;
    const int K = J.K, nt = K / BK;
    unsigned voffA[2], voffB[2];
#pragma unroll
    for (int i = 0; i < 2; ++i) { int R, C; stage_rc(tid * 16 + i * 8192, R, C);
        const int Rb = (R & ~31) + perm32(R & 31);
        voffA[i] = (unsigned)(R * J.lda + C) * 2u; voffB[i] = (unsigned)(Rb * J.ldb + C) * 2u; }
    const size_t kstep = (size_t)(BK * 2);
    const size_t hstepA = (size_t)HALF * J.lda * 2, hstepB = (size_t)HALF * J.ldb * 2;
    const unsigned ldsw = (unsigned)wid * 1024u;
    const int aoff = lds_byte(wr * 64 + fr, fq * 8), boff = lds_byte(wc * 32 + fr, fq * 8);
#define PG8_SA(b, h) (((b) * 2 + (h)) * HTB)
#define PG8_SB(b, h) ((4 + (b) * 2 + (h)) * HTB)
#define PG8_STAGE(bufoff, gbase, voff) do { _Pragma("unroll") for (int _i = 0; _i < 2; ++_i) \
        __builtin_amdgcn_global_load_lds((const unsigned*)((const char*)(gbase) + (voff)[_i]), (LAS unsigned*)(lds + (bufoff) + ldsw + _i * 8192), 16, 0, 0); } while (0)
#define PG8_LDA(dst, b, h) do { _Pragma("unroll") for (int m = 0; m < 4; ++m) _Pragma("unroll") for (int k = 0; k < 2; ++k) dst[m][k] = *(const LAS bf16x8*)(lds + PG8_SA(b, h) + aoff + m * 2048 + k * 1024); } while (0)
#define PG8_LDB(dst, b, h) do { _Pragma("unroll") for (int n = 0; n < 2; ++n) _Pragma("unroll") for (int k = 0; k < 2; ++k) dst[n][k] = *(const LAS bf16x8*)(lds + PG8_SB(b, h) + boff + n * 2048 + k * 1024); } while (0)
#define PG8_MMA(ai, bj, At, Bt) do { __builtin_amdgcn_s_setprio(1); _Pragma("unroll") for (int m = 0; m < 4; ++m) _Pragma("unroll") for (int n = 0; n < 2; ++n) _Pragma("unroll") for (int k = 0; k < 2; ++k) \
        acc[ai][bj][m][n] = __builtin_amdgcn_mfma_f32_16x16x32_bf16(Bt[n][k], At[m][k], acc[ai][bj][m][n], 0, 0, 0); __builtin_amdgcn_s_setprio(0); } while (0)
#define PG8_WAIT_V(n) asm volatile("s_waitcnt vmcnt(" #n ")" ::: "memory")
#define PG8_WAIT_L(n) asm volatile("s_waitcnt lgkmcnt(" #n ")" ::: "memory")
#define PG8_BAR __builtin_amdgcn_s_barrier()
#define PG8_SCHED __builtin_amdgcn_sched_barrier(0)
    Unit cur, nxt; int ui = 0;
    if (!J.next(0, cur)) return;
    f32x4 acc[2][2][4][2];
#pragma unroll
    for (int a = 0; a < 2; ++a)
#pragma unroll
        for (int b = 0; b < 2; ++b)
#pragma unroll
            for (int m = 0; m < 4; ++m)
#pragma unroll
                for (int n = 0; n < 2; ++n) acc[a][b][m][n] = (f32x4){0.f, 0.f, 0.f, 0.f};
    bf16x8 At[4][2], B0[2][2], B1[2][2];
    const char* cA; const char* cB;
    J.ptrs(cur, cA, cB);
    PG8_STAGE(PG8_SB(0, 0), cB, voffB); PG8_STAGE(PG8_SB(0, 1), cB + hstepB, voffB); PG8_STAGE(PG8_SA(0, 0), cA, voffA); PG8_STAGE(PG8_SA(0, 1), cA + hstepA, voffA);
    if (wr == 1) PG8_BAR;
    PG8_WAIT_V(2); PG8_BAR;
    PG8_STAGE(PG8_SB(1, 0), cB + kstep, voffB); PG8_STAGE(PG8_SA(1, 0), cA + kstep, voffA); PG8_STAGE(PG8_SB(1, 1), cB + hstepB + kstep, voffB);
    PG8_WAIT_V(6); PG8_BAR;
    for (;;) {
        const bool has_next = J.next(ui + 1, nxt);
        const char* nA = cA; const char* nB = cB;
        if (has_next) J.ptrs(nxt, nA, nB);
        for (int t = 0; t < nt; t += 2) {
            if constexpr (Epi::HOOK) { if (E.want(t)) E.hook(acc, cur, t, wr, wc, fr, fq); }
            const bool last = (t == nt - 2);
            const char* a1 = cA + (size_t)(t + 1) * kstep;
            const char* a2 = last ? nA : cA + (size_t)(t + 2) * kstep; const char* b2 = last ? nB : cB + (size_t)(t + 2) * kstep;
            const char* a3 = a2 + kstep; const char* b3 = b2 + kstep;
            PG8_LDB(B0, 0, 0); PG8_LDB(B1, 0, 1); PG8_SCHED; PG8_LDA(At, 0, 0); PG8_STAGE(PG8_SA(1, 1), a1 + hstepA, voffA);
            PG8_WAIT_V(8); PG8_WAIT_L(0); PG8_BAR; PG8_MMA(0, 0, At, B0); PG8_MMA(0, 1, At, B1); PG8_BAR; PG8_SCHED;
            PG8_LDA(At, 0, 1); PG8_STAGE(PG8_SB(0, 0), b2, voffB); PG8_STAGE(PG8_SB(0, 1), b2 + hstepB, voffB); PG8_STAGE(PG8_SA(0, 0), a2, voffA);
            PG8_WAIT_V(8); PG8_WAIT_L(0); PG8_BAR; PG8_MMA(1, 0, At, B0); PG8_MMA(1, 1, At, B1); PG8_BAR; PG8_SCHED;
            PG8_LDB(B0, 1, 0); PG8_LDB(B1, 1, 1); PG8_SCHED; PG8_LDA(At, 1, 0); PG8_STAGE(PG8_SA(0, 1), a2 + hstepA, voffA);
            PG8_WAIT_V(8); PG8_WAIT_L(0); PG8_BAR; PG8_MMA(0, 0, At, B0); PG8_MMA(0, 1, At, B1); PG8_BAR; PG8_SCHED;
            PG8_LDA(At, 1, 1); PG8_STAGE(PG8_SB(1, 0), b3, voffB); PG8_STAGE(PG8_SB(1, 1), b3 + hstepB, voffB); PG8_STAGE(PG8_SA(1, 0), a3, voffA);
            PG8_WAIT_V(8); PG8_WAIT_L(0); PG8_BAR; PG8_MMA(1, 0, At, B0); PG8_MMA(1, 1, At, B1); PG8_BAR; PG8_SCHED;
        }
        if (wr == 0) PG8_BAR;
        { int fr_ = fr, fq_ = fq; asm volatile("" : "+v"(fr_), "+v"(fq_));
          E(acc, cur, wr, wc, fr_, fq_); }
        if (!has_next) break;
#pragma unroll
        for (int a = 0; a < 2; ++a)
#pragma unroll
            for (int b = 0; b < 2; ++b)
#pragma unroll
                for (int m = 0; m < 4; ++m)
#pragma unroll
                    for (int n = 0; n < 2; ++n) acc[a][b][m][n] = (f32x4){0.f, 0.f, 0.f, 0.f};
        cur = nxt; cA = nA; cB = nB; ++ui;
        if (wr == 1) PG8_BAR;
    }
    PG8_WAIT_V(0);
    PG8_BAR;
#undef PG8_SA
#undef PG8_SB
#undef PG8_STAGE
#undef PG8_LDA
#undef PG8_LDB
#undef PG8_MMA
#undef PG8_WAIT_V
#undef PG8_WAIT_L
#undef PG8_BAR
#undef PG8_SCHED
}
}
using pg8::Unit;

struct Job {
    const bf16_t* A; const bf16_t* B; int lda, ldb, K;
    int nM, nN, nX, G, c;
    long sAm, sAn, sAx, sBm, sBn, sBx;
    int order;
    __device__ __forceinline__ bool next(int i, Unit& u) const {
        const int L = i * G + c; const int per = nM * nN;
        if (L >= per * nX) return false;
        const int x = L / per; int r = L - x * per;
        u.x = x;
        if (order == 1) {
            { const int q = per / 8, rr = per % 8, xcd = r % 8, off = r / 8; r = (xcd < rr ? xcd * (q + 1) : rr * (q + 1) + (xcd - rr) * q) + off; }
            const int nig = 8 * nN, gid = r / nig, fm = gid * 8, gsz = (nM - fm) < 8 ? (nM - fm) : 8;
            u.pm = fm + ((r % nig) % gsz); u.pn = (r % nig) / gsz;
        } else { u.pm = r % nM; u.pn = r / nM; }
        return true;
    }
    __device__ __forceinline__ void ptrs(const Unit& u, const char*& a, const char*& b) const {
        a = (const char*)(A + (long)u.pm * sAm + (long)u.pn * sAn + (long)u.x * sAx);
        b = (const char*)(B + (long)u.pm * sBm + (long)u.pn * sBn + (long)u.x * sBx);
    }
};

#define EPI_ARGS const f32x4 (&acc)[2][2][4][2], const Unit& u, int wr, int wc, int fr, int fq

struct EpiIn {
    static constexpr bool HOOK = false;
    bf16_t* ACT; float* out_dk; float* out_nk; const float* rope; int layer; bf16_t* GF;
    __device__ __forceinline__ void operator()(EPI_ARGS) const {
        const int seg = u.pn >> 1; const bool lat = u.pm >= 32;
        int pm_ = u.pm, pn_ = u.pn; asm volatile("" : "+s"(pm_), "+s"(pn_));
        bf16_t* gft = (seg >= 8) ? GF + (size_t)(pm_ * GF_TILES + (pn_ - 16)) * GF_TILE : nullptr;
        const int bstride = (seg >= 8) ? 512 : 128;
        int mode = 0;
        if (seg == 8 || seg == 9) mode = 1;
        else if (seg >= 10) mode = 2;
        else if (seg == 2 || seg == 5) mode = 3;
        const bool dorope = lat && (seg == 2 || seg == 3);
        float* fo = nullptr;
        if (!lat && seg == 3) fo = out_dk; else if (!lat && seg == 6) fo = out_nk;
        const int cq = wc * 32 + 8 * fq;
#pragma unroll
        for (int ai = 0; ai < 2; ++ai)
#pragma unroll
            for (int m = 0; m < 4; ++m) {
                const int rt = ai * 128 + wr * 64 + m * 16 + fr;
                const size_t row = (size_t)u.pm * 256 + rt;
                bf16_t* arow = gft ? gft + gf_off(wr, wc, ai, m, 0, fr + 16 * fq) : ACT + row * LDACT + (size_t)u.pn * 256 + cq;
                f32x4 cs0 = {1.f, 1.f, 1.f, 1.f}, cs1 = cs0, sn0 = {0.f, 0.f, 0.f, 0.f}, sn1 = sn0;
                if (dorope) { const int t = (int)(row - TCTX) & 4095; const int pos = (wc & 1) ? (t & 63) : (t >> 6);
                    const float* rp = rope + pos * 32 + 8 * (fq & 1); const float sg = (fq < 2) ? -1.0f : 1.0f;
                    cs0 = *(const f32x4*)rp; cs1 = *(const f32x4*)(rp + 4); sn0 = *(const f32x4*)(rp + 16) * sg; sn1 = *(const f32x4*)(rp + 20) * sg; }
#pragma unroll
                for (int bj = 0; bj < 2; ++bj) {
                    f32x4 v0 = acc[ai][bj][m][0], v1 = acc[ai][bj][m][1];
                    if (fo) {
                        float* fp = fo + ((size_t)(u.pm * 4 + layer) * 256 + rt) * 512 + (u.pn & 1) * 256 + bj * 128 + cq;
                        *(f32x4*)fp = v0; *(f32x4*)(fp + 4) = v1;
                    }
                    if (dorope) {
                        f32x4 p0, p1;
#pragma unroll
                        for (int j = 0; j < 4; ++j) { p0[j] = __shfl_xor(v0[j], 32); p1[j] = __shfl_xor(v1[j], 32); }
                        v0 = v0 * cs0 + p0 * sn0; v1 = v1 * cs1 + p1 * sn1;
                    }
                    if (mode == 1) {
#pragma unroll
                        for (int j = 0; j < 4; ++j) { v0[j] = siluf_(v0[j]); v1[j] = siluf_(v1[j]); }
                    } else if (mode == 2) {
#pragma unroll
                        for (int j = 0; j < 4; ++j) { v0[j] = einvsig_(v0[j]); v1[j] = einvsig_(v1[j]); }
                    } else if (mode == 3) { v0 = v0 * QSCALE; v1 = v1 * QSCALE; }
                    u32x4 w; w.x = pk2(v0[0], v0[1]); w.y = pk2(v0[2], v0[3]); w.z = pk2(v1[0], v1[1]); w.w = pk2(v1[2], v1[3]);
                    *(u32x4*)(arow + bj * bstride) = w;
                }
            }
    }
};
struct EpiInT {
    static constexpr bool HOOK = false;
    bf16_t* XT; float* out_dv; float* out_nv; int layer;
    __device__ __forceinline__ void operator()(EPI_ARGS) const {
        float* fo = nullptr;
        if (u.pn < 32 && u.pm >= 2) fo = (u.pm < 4) ? out_dv : out_nv;
        const int cq = wc * 32 + 8 * fq;
#pragma unroll
        for (int ai = 0; ai < 2; ++ai)
#pragma unroll
            for (int m = 0; m < 4; ++m) {
                const int rt = ai * 128 + wr * 64 + m * 16 + fr;
                const int feat = u.pm * 256 + rt;
                bf16_t* xrow = XT + (size_t)feat * TOK + (size_t)u.pn * 256 + cq;
#pragma unroll
                for (int bj = 0; bj < 2; ++bj) {
                    const f32x4 v0 = acc[ai][bj][m][0], v1 = acc[ai][bj][m][1];
                    u32x4 w; w.x = pk2(v0[0], v0[1]); w.y = pk2(v0[2], v0[3]); w.z = pk2(v1[0], v1[1]); w.w = pk2(v1[2], v1[3]);
                    *(u32x4*)(xrow + bj * 128) = w;
                    if (fo) { const int s0 = bj * 128 + cq; const int f512 = feat & 511;
                        float* fp = fo + ((size_t)(u.pn * 4 + layer) * 256 + s0) * 512 + f512;
                        fp[0] = v0[0]; fp[512] = v0[1]; fp[1024] = v0[2]; fp[1536] = v0[3];
                        fp[2048] = v1[0]; fp[2560] = v1[1]; fp[3072] = v1[2]; fp[3584] = v1[3]; }
                }
            }
    }
};
struct EpiCdft {
    static constexpr bool HOOK = false;
    bf16_t* YTC; bf16_t* YTL;
    __device__ __forceinline__ void operator()(EPI_ARGS) const {
        const int g = u.pm >> 1, part = u.pm & 1;
        bf16_t* base; size_t ld;
        if (u.pn < 32) { base = YTC + ((size_t)u.pn * 1024 + g * 256) * 512 + part * 256; ld = 512; }
        else { const int q = u.pn - 32; base = YTL + ((size_t)(q >> 4) * 1024 + g * 256) * 8192 + part * 4096 + (q & 15) * 256; ld = 8192; }
#pragma unroll
        for (int ai = 0; ai < 2; ++ai)
#pragma unroll
            for (int m = 0; m < 4; ++m) {
                const int rt = ai * 128 + wr * 64 + m * 16 + fr;
                bf16_t* yrow = base + (size_t)rt * ld + wc * 32 + 8 * fq;
#pragma unroll
                for (int bj = 0; bj < 2; ++bj) { const f32x4 v0 = acc[ai][bj][m][0], v1 = acc[ai][bj][m][1];
                    u32x4 w; w.x = pk2(v0[0], v0[1]); w.y = pk2(v0[2], v0[3]); w.z = pk2(v1[0], v1[1]); w.w = pk2(v1[2], v1[3]);
                    *(u32x4*)(yrow + bj * 128) = w; }
            }
    }
};
struct EpiPdftCtx {
    static constexpr bool HOOK = false;
    const bf16_t* ACT; bf16_t* YCAT; int tokbase, xstride;
    __device__ __forceinline__ void operator()(EPI_ARGS) const {
        const unsigned r0 = (unsigned)tokbase + (unsigned)u.x * xstride + (unsigned)u.pm * 256 + wr * 64 + fr;
        const unsigned c0 = u.pn * 256 + wc * 32 + 8 * fq;
        const bf16_t* gft = ACT + (size_t)(((tokbase + u.x * xstride) >> 8) + u.pm) * GF_TILES * GF_TILE + (size_t)u.pn * GF_TILE;
#pragma unroll
        for (int ai = 0; ai < 2; ++ai) {
            u32x4 gt[4][2];
#pragma unroll
            for (int m = 0; m < 4; ++m)
#pragma unroll
                for (int bj = 0; bj < 2; ++bj) gt[m][bj] = *(const u32x4*)(gft + gf_off(wr, wc, ai, m, bj, fr + 16 * fq));
#pragma unroll
            for (int m = 0; m < 4; ++m)
#pragma unroll
                for (int bj = 0; bj < 2; ++bj) { const f32x4 v0 = acc[ai][bj][m][0], v1 = acc[ai][bj][m][1]; const u32x4 g = gt[m][bj];
                    u32x4 w; w.x = pk2(v0[0] * bflo(g.x), v0[1] * bfhi(g.x)); w.y = pk2(v0[2] * bflo(g.y), v0[3] * bfhi(g.y));
                    w.z = pk2(v1[0] * bflo(g.z), v1[1] * bfhi(g.z)); w.w = pk2(v1[2] * bflo(g.w), v1[3] * bfhi(g.w));
                    *(u32x4*)(YCAT + (size_t)(r0 + ai * 128 + m * 16) * LDY + Y_F + c0 + bj * 128) = w; }
        }
    }
};
struct EpiPdftLat {
    static constexpr bool HOOK = false;
    float* PF;
    __device__ __forceinline__ void operator()(EPI_ARGS) const {
        const int part = u.x >> 1, b = u.x & 1;
#pragma unroll
        for (int ai = 0; ai < 2; ++ai)
#pragma unroll
            for (int m = 0; m < 4; ++m) {
                const int rt = ai * 128 + wr * 64 + m * 16 + fr;
                float* prow = PF + ((size_t)part * 8192 + (size_t)b * 4096 + (size_t)u.pm * 256 + rt) * 1024 + u.pn * 256 + wc * 32 + 8 * fq;
#pragma unroll
                for (int bj = 0; bj < 2; ++bj) { *(f32x4*)(prow + bj * 128) = acc[ai][bj][m][0]; *(f32x4*)(prow + bj * 128 + 4) = acc[ai][bj][m][1]; }
            }
    }
};
struct EpiMix {
    static constexpr bool HOOK = true;
    const bf16_t* ACT; bf16_t* MIXB;
    __device__ __forceinline__ bool want(int t) const { return t == 8 || t == 16 || t == 24; }
    __device__ __forceinline__ void hook(f32x4 (&acc)[2][2][4][2], const Unit& u, int t, int wr, int wc, int fr, int fq) const {
        const int b = (t >> 3) - 1;
        unsigned r0 = (unsigned)u.pm * 256 + wr * 64 + fr, cq = wc * 32 + 8 * fq; int lane_ = fr + 16 * fq;
        asm volatile("" : "+v"(r0), "+v"(cq), "+v"(lane_));
        const bf16_t* gp = ACT + (size_t)(u.pm * GF_TILES + 4 + b * 4 + u.pn) * GF_TILE;
        (void)r0; (void)cq;
        u32x4 ga[2][2][2], gb[2][2][2];
#define MIX_LD(buf, ai, mp) do { _Pragma("unroll") for (int mm = 0; mm < 2; ++mm) _Pragma("unroll") for (int bj = 0; bj < 2; ++bj) { \
            const bf16_t* p = gp + gf_off(wr, wc, ai, (mp) * 2 + mm, bj, lane_); ga[buf][mm][bj] = *(const u32x4*)p; gb[buf][mm][bj] = *(const u32x4*)(p + 4 * GF_TILE); } } while (0)
#define MIX_AP(buf, ai, mp) do { _Pragma("unroll") for (int mm = 0; mm < 2; ++mm) _Pragma("unroll") for (int bj = 0; bj < 2; ++bj) { \
            const u32x4 a = ga[buf][mm][bj], d = gb[buf][mm][bj]; f32x4& v0 = acc[ai][bj][(mp) * 2 + mm][0]; f32x4& v1 = acc[ai][bj][(mp) * 2 + mm][1]; \
            v0[0] *= bflo(d.x) * __builtin_amdgcn_rcpf(bflo(a.x)); v0[1] *= bfhi(d.x) * __builtin_amdgcn_rcpf(bfhi(a.x)); \
            v0[2] *= bflo(d.y) * __builtin_amdgcn_rcpf(bflo(a.y)); v0[3] *= bfhi(d.y) * __builtin_amdgcn_rcpf(bfhi(a.y)); \
            v1[0] *= bflo(d.z) * __builtin_amdgcn_rcpf(bflo(a.z)); v1[1] *= bfhi(d.z) * __builtin_amdgcn_rcpf(bfhi(a.z)); \
            v1[2] *= bflo(d.w) * __builtin_amdgcn_rcpf(bflo(a.w)); v1[3] *= bfhi(d.w) * __builtin_amdgcn_rcpf(bfhi(a.w)); } } while (0)
        MIX_LD(0, 0, 0); MIX_LD(1, 0, 1);
        MIX_AP(0, 0, 0); asm volatile("" ::: "memory"); MIX_LD(0, 1, 0);
        MIX_AP(1, 0, 1); asm volatile("" ::: "memory"); MIX_LD(1, 1, 1);
        MIX_AP(0, 1, 0); MIX_AP(1, 1, 1);
        asm volatile("" ::: "memory");
#undef MIX_LD
#undef MIX_AP
    }
    __device__ __forceinline__ void operator()(EPI_ARGS) const {
        const unsigned r0 = (unsigned)u.pm * 256 + wr * 64 + fr;
        const unsigned c0 = u.pn * 256 + wc * 32 + 8 * fq;
        const bf16_t* gp = ACT + (size_t)(u.pm * GF_TILES + 4 + 12 + u.pn) * GF_TILE;
#pragma unroll
        for (int ai = 0; ai < 2; ++ai) {
            u32x4 ga[4][2];
#pragma unroll
            for (int m = 0; m < 4; ++m)
#pragma unroll
                for (int bj = 0; bj < 2; ++bj) ga[m][bj] = *(const u32x4*)(gp + gf_off(wr, wc, ai, m, bj, fr + 16 * fq));
#pragma unroll
            for (int m = 0; m < 4; ++m)
#pragma unroll
                for (int bj = 0; bj < 2; ++bj) { const f32x4 v0 = acc[ai][bj][m][0], v1 = acc[ai][bj][m][1]; const u32x4 a = ga[m][bj];
#define RC_(x) __builtin_amdgcn_rcpf(x)
                    u32x4 w; w.x = pk2(v0[0] * RC_(bflo(a.x)), v0[1] * RC_(bfhi(a.x))); w.y = pk2(v0[2] * RC_(bflo(a.y)), v0[3] * RC_(bfhi(a.y)));
                    w.z = pk2(v1[0] * RC_(bflo(a.z)), v1[1] * RC_(bfhi(a.z))); w.w = pk2(v1[2] * RC_(bflo(a.w)), v1[3] * RC_(bfhi(a.w)));
#undef RC_
                    *(u32x4*)(MIXB + (size_t)(r0 + ai * 128 + m * 16) * 1024 + c0 + bj * 128) = w; }
        }
    }
};
struct EpiOut {
    static constexpr bool HOOK = false;
    bf16_t* O;
    __device__ __forceinline__ void operator()(EPI_ARGS) const {
#pragma unroll
        for (int ai = 0; ai < 2; ++ai)
#pragma unroll
            for (int m = 0; m < 4; ++m) {
                const int rt = ai * 128 + wr * 64 + m * 16 + fr;
                bf16_t* orow = O + ((size_t)u.pm * 256 + rt) * 1024 + u.pn * 256 + wc * 32 + 8 * fq;
#pragma unroll
                for (int bj = 0; bj < 2; ++bj) { const f32x4 v0 = acc[ai][bj][m][0], v1 = acc[ai][bj][m][1];
                    u32x4 w; w.x = pk2(v0[0], v0[1]); w.y = pk2(v0[2], v0[3]); w.z = pk2(v1[0], v1[1]); w.w = pk2(v1[2], v1[3]);
                    *(u32x4*)(orow + bj * 128) = w; }
            }
    }
};

struct KVSrc { const bf16_t* k0; int ldk0; const bf16_t* v0; int ldv0; int n0; const bf16_t* k1; int ldk1; const bf16_t* v1; int ldv1; };

#define MFMA32(a, b, c) __builtin_amdgcn_mfma_f32_32x32x16_bf16((a), (b), (c), 0, 0, 0)

template <int DV, int KW, int MODE>
__device__ __forceinline__ void attn_core(LAS unsigned char* lds, const bf16_t* qrow, const KVSrc& S, int nT, int kcol, int vrow,
                                          const LAS float* rpbh, int dr0, int qc, f32x16 (&o)[DV / 32], float& lsum) {
    constexpr int KS = KW + 8, VS = 72, NCH = KW / 64;
    constexpr int KBYTES = 64 * KS * 2, VBYTES = KW * VS * 2, STAGE = KBYTES + VBYTES;
    static_assert(2 * STAGE <= 144 * 1024, "attention LDS");
    const int tid = ltid(), lane = tid & 63, r32 = lane & 31, hi = lane >> 5;
    u32x4 kr[NCH], vr[NCH];
#define A_GLOAD(t) do { const bf16_t* kp_; const bf16_t* vp_; int lk_, lv_; \
        if ((t) < S.n0) { kp_ = S.k0 + (size_t)(t) * 64 * S.ldk0; lk_ = S.ldk0; vp_ = S.v0 + (size_t)(t) * 64; lv_ = S.ldv0; } \
        else { kp_ = S.k1 + (size_t)((t) - S.n0) * 64 * S.ldk1; lk_ = S.ldk1; vp_ = S.v1 + (size_t)((t) - S.n0) * 64; lv_ = S.ldv1; } \
        _Pragma("unroll") for (int c_ = 0; c_ < NCH; ++c_) { const int id_ = tid + NTHR * c_; \
            kr[c_] = *(const u32x4*)(kp_ + (size_t)(id_ / (KW / 8)) * lk_ + (id_ % (KW / 8)) * 8); \
            vr[c_] = *(const u32x4*)(vp_ + (size_t)(id_ >> 3) * lv_ + (id_ & 7) * 8); } } while (0)
#define A_LSTORE(buf) do { LAS bf16_t* kt_ = (LAS bf16_t*)(lds + (buf) * STAGE); LAS bf16_t* vt_ = (LAS bf16_t*)(lds + (buf) * STAGE + KBYTES); \
        _Pragma("unroll") for (int c_ = 0; c_ < NCH; ++c_) { const int id_ = tid + NTHR * c_; \
            *(LAS u32x4*)(kt_ + (id_ / (KW / 8)) * KS + (id_ % (KW / 8)) * 8) = kr[c_]; \
            { LAS bf16_t* vd_ = vt_ + (id_ >> 3) * VS + 16 * ((id_ & 7) >> 1) + 4 * (id_ & 1); \
              *(LAS u32x2*)vd_ = (u32x2){vr[c_].x, vr[c_].y}; *(LAS u32x2*)(vd_ + 8) = (u32x2){vr[c_].z, vr[c_].w}; } } } while (0)
    bf16x8 qf[4];
#pragma unroll
    for (int d0 = 0; d0 < 4; ++d0) qf[d0] = *(const bf16x8*)(qrow + d0 * 16 + hi * 8);
    float mrun = 0.f; lsum = 0.f;
    f32x16 negm;
#pragma unroll
    for (int j = 0; j < 16; ++j) negm[j] = 0.f;
#pragma unroll
    for (int b = 0; b < DV / 32; ++b)
#pragma unroll
        for (int j = 0; j < 16; ++j) o[b][j] = 0.f;
    A_GLOAD(0); A_LSTORE(0); if (nT > 1) A_GLOAD(1); __syncthreads();
    for (int t = 0; t < nT; ++t) {
        const int buf = t & 1;
        if (t + 1 < nT) A_LSTORE(buf ^ 1);
        if (t + 2 < nT) A_GLOAD(t + 2);
        const LAS bf16_t* Kt = (const LAS bf16_t*)(lds + buf * STAGE);
        const LAS bf16_t* Vt = (const LAS bf16_t*)(lds + buf * STAGE + KBYTES);
        f32x16 p0, p1;
#pragma unroll
        for (int d0 = 0; d0 < 4; ++d0) {
            const bf16x8 a0 = *(const LAS bf16x8*)(Kt + r32 * KS + kcol + d0 * 16 + hi * 8);
            const bf16x8 a1 = *(const LAS bf16x8*)(Kt + (32 + r32) * KS + kcol + d0 * 16 + hi * 8);
            if (d0 == 0) { p0 = MFMA32(a0, qf[0], negm); p1 = MFMA32(a1, qf[0], negm); }
            else { p0 = MFMA32(a0, qf[d0], p0); p1 = MFMA32(a1, qf[d0], p1); }
        }
        if (MODE == 2 && t < 8) {
            const int c0 = min(max(qc - 8, 0), 48);
            const LAS float* rb = rpbh + (dr0 + t + 7) * 31 + 15 - qc;
#pragma unroll
            for (int j = 0; j < 16; ++j) { const int kc = crow(j, hi);
                p0[j] = (kc >= c0 && kc < c0 + 16) ? p0[j] + rb[kc] : -INFINITY;
                const int kc1 = kc + 32;
                p1[j] = (kc1 >= c0 && kc1 < c0 + 16) ? p1[j] + rb[kc1] : -INFINITY; }
        }
        float ma = __builtin_fmaxf(__builtin_fmaxf(p0[0], p0[1]), p1[0]), mb = __builtin_fmaxf(__builtin_fmaxf(p0[2], p0[3]), p1[1]);
        ma = __builtin_fmaxf(__builtin_fmaxf(ma, p1[2]), p1[3]);
#pragma unroll
        for (int j = 4; j < 16; j += 4) { ma = __builtin_fmaxf(__builtin_fmaxf(ma, p0[j]), p0[j + 1]); mb = __builtin_fmaxf(__builtin_fmaxf(mb, p0[j + 2]), p0[j + 3]);
            ma = __builtin_fmaxf(__builtin_fmaxf(ma, p1[j]), p1[j + 1]); mb = __builtin_fmaxf(__builtin_fmaxf(mb, p1[j + 2]), p1[j + 3]); }
        float mx = __builtin_fmaxf(ma, mb);
        { auto rr_ = __builtin_amdgcn_permlane32_swap(__float_as_uint(mx), __float_as_uint(mx), false, false); mx = fmaxf(__uint_as_float(rr_[0]), __uint_as_float(rr_[1])); }
        if (t == 0 || __any(mx > 6.0f)) {
            const float dl = (t == 0) ? mx : __builtin_fmaxf(mx, 0.f);
            mrun += dl;
#pragma unroll
            for (int j = 0; j < 16; ++j) { p0[j] -= dl; p1[j] -= dl; }
            if (t > 0) { const float f = fexp2(-dl); lsum *= f;
#pragma unroll
                for (int b = 0; b < DV / 32; ++b)
#pragma unroll
                    for (int j = 0; j < 16; ++j) o[b][j] *= f; }
#pragma unroll
            for (int j = 0; j < 16; ++j) negm[j] = -mrun;
        }
        f32x2_t sa = {0.f, 0.f}, sb = {0.f, 0.f};
#pragma unroll
        for (int j = 0; j < 16; j += 2) { p0[j] = fexp2(p0[j]); p0[j + 1] = fexp2(p0[j + 1]); p1[j] = fexp2(p1[j]); p1[j + 1] = fexp2(p1[j + 1]);
            sa += (f32x2_t){p0[j], p0[j + 1]}; sb += (f32x2_t){p1[j], p1[j + 1]}; }
        sa += sb; lsum += sa[0] + sa[1];
        bf16x8 pf[2][2];
#pragma unroll
        for (int s = 0; s < 2; ++s) {
            u32x4 w0, w1;
            w0.x = pk2(p0[8 * s + 0], p0[8 * s + 1]); w0.y = pk2(p0[8 * s + 2], p0[8 * s + 3]); w0.z = pk2(p0[8 * s + 4], p0[8 * s + 5]); w0.w = pk2(p0[8 * s + 6], p0[8 * s + 7]);
            w1.x = pk2(p1[8 * s + 0], p1[8 * s + 1]); w1.y = pk2(p1[8 * s + 2], p1[8 * s + 3]); w1.z = pk2(p1[8 * s + 4], p1[8 * s + 5]); w1.w = pk2(p1[8 * s + 6], p1[8 * s + 7]);
            pf[0][s] = __builtin_bit_cast(bf16x8, w0); pf[1][s] = __builtin_bit_cast(bf16x8, w1);
        }
#pragma unroll
        for (int b = 0; b < DV / 32; ++b) {
            const LAS bf16_t* vp = Vt + (vrow + 32 * b + r32) * VS + 8 * hi;
#pragma unroll
            for (int kh = 0; kh < 2; ++kh)
#pragma unroll
                for (int s = 0; s < 2; ++s) {
                    const bf16x8 va = *(const LAS bf16x8*)(vp + 32 * kh + 16 * s);
                    o[b] = MFMA32(va, pf[kh][s], o[b]);
                }
        }
        __syncthreads();
    }
#undef A_GLOAD
#undef A_LSTORE
}

__device__ __forceinline__ void attn_store64(const f32x16 (&o)[2], float lsum, const bf16_t* gate, bf16_t* yout, int hi) {
    const float l = lsum + __shfl_xor(lsum, 32); const float inv = __builtin_amdgcn_rcpf(l);
    u32x2 gt[2][4];
#pragma unroll
    for (int b = 0; b < 2; ++b)
#pragma unroll
        for (int g = 0; g < 4; ++g) gt[b][g] = *(const u32x2*)(gate + 32 * b + 8 * g + 4 * hi);
#pragma unroll
    for (int b = 0; b < 2; ++b)
#pragma unroll
        for (int g = 0; g < 4; ++g) { const int dv = 32 * b + 8 * g + 4 * hi; const u32x2 q = gt[b][g];
            u32x2 w; w.x = pk2(o[b][4 * g] * inv * siluf_(bflo(q.x)), o[b][4 * g + 1] * inv * siluf_(bfhi(q.x)));
            w.y = pk2(o[b][4 * g + 2] * inv * siluf_(bflo(q.y)), o[b][4 * g + 3] * inv * siluf_(bfhi(q.y)));
            *(u32x2*)(yout + dv) = w; }
}

__device__ __forceinline__ void diff_unit(LAS unsigned char* lds, const bf16_t* ACT, bf16_t* YCAT, const KVSrc& S, int nT, size_t tok0, int h,
                                          float lam, float lam_init, const float* subln) {
    const int tid = ltid(), wid = __builtin_amdgcn_readfirstlane(tid >> 6), lane = tid & 63, r32 = lane & 31, hi = lane >> 5;
    const int map = wid >> 2, qs = wid & 3;
    const size_t tok = tok0 + qs * 32 + r32;
    f32x16 o[4]; float lsum;
    attn_core<128, 128, 0>(lds, ACT + tok * LDACT + A_DQ + h * 128 + map * 64, S, nT, map * 64, 0, nullptr, 0, 0, o, lsum);
    const float l = lsum + __shfl_xor(lsum, 32); const float inv = __builtin_amdgcn_rcpf(l);
    LAS float* X = (LAS float*)lds;
    if (map == 1) {
#pragma unroll
        for (int b = 0; b < 4; ++b)
#pragma unroll
            for (int j = 0; j < 16; ++j) X[((qs * 64) + b * 16 + j) * 64 + lane] = o[b][j] * inv;
    }
    __syncthreads();
    if (map == 0) {
        float ssq = 0.f;
#pragma unroll
        for (int b = 0; b < 4; ++b)
#pragma unroll
            for (int j = 0; j < 16; ++j) { const float d = o[b][j] * inv - lam * X[((qs * 64) + b * 16 + j) * 64 + lane]; o[b][j] = d; ssq += d * d; }
        ssq += __shfl_xor(ssq, 32);
        const float rs = rsqrtf(ssq * (1.0f / 128.0f) + EPSN) * (1.0f - lam_init);
        const bf16_t* gate = ACT + tok * LDACT + A_DG + h * 128;
        bf16_t* yout = YCAT + tok * LDY + Y_D + h * 128;
        u32x2 gt[4][4];
#pragma unroll
        for (int b = 0; b < 4; ++b)
#pragma unroll
            for (int g = 0; g < 4; ++g) gt[b][g] = *(const u32x2*)(gate + 32 * b + 8 * g + 4 * hi);
#pragma unroll
        for (int b = 0; b < 4; ++b)
#pragma unroll
            for (int g = 0; g < 4; ++g) { const int dv = 32 * b + 8 * g + 4 * hi;
                const u32x2 q = gt[b][g]; const f32x4 sg = *(const f32x4*)(subln + dv);
                u32x2 w; w.x = pk2(o[b][4 * g] * rs * sg[0] * siluf_(bflo(q.x)), o[b][4 * g + 1] * rs * sg[1] * siluf_(bfhi(q.x)));
                w.y = pk2(o[b][4 * g + 2] * rs * sg[2] * siluf_(bflo(q.y)), o[b][4 * g + 3] * rs * sg[3] * siluf_(bfhi(q.y)));
                *(u32x2*)(yout + dv) = w; }
    }
    __syncthreads();
}

__device__ __forceinline__ void spatial_unit(LAS unsigned char* lds, int chunk, const bf16_t* ACT, const bf16_t* SGVT, const bf16_t* SGW,
                                             const float* sgb, const float* sgng, bf16_t* YCAT) {
    const int tid = ltid(), wid = __builtin_amdgcn_readfirstlane(tid >> 6), lane = tid & 63, r32 = lane & 31, hi = lane >> 5;
    LAS float* part = (LAS float*)lds;
    LAS float* rr = part + 512;
    const size_t t0 = (size_t)chunk * 128;
    { const int tk = tid & 127, cq = tid >> 7; float s = 0.f;
#pragma unroll 16
      for (int c = cq * 128; c < cq * 128 + 128; ++c) { const float v = bf2f(SGVT[(size_t)c * TOK + t0 + tk]); s += v * v; }
      part[cq * 128 + tk] = s; }
    __syncthreads();
    if (tid < 128) rr[tid] = rsqrtf((part[tid] + part[128 + tid] + part[256 + tid] + part[384 + tid]) * (1.0f / 512.0f) + EPSN);
    __syncthreads();
    const int g = wid;
    const bf16_t* Wg = SGW + (size_t)g * 128 * 128;
#pragma unroll 1
    for (int cb = 0; cb < 2; ++cb) {
        bf16x8 vb[8];
        const unsigned c = g * 64 + cb * 32 + r32;
#pragma unroll
        for (int s = 0; s < 8; ++s) {
            const f32x4 r0 = *(const LAS f32x4*)(rr + 16 * s + 8 * hi), r1 = *(const LAS f32x4*)(rr + 16 * s + 8 * hi + 4);
            const u32x4 raw = *(const u32x4*)(SGVT + (size_t)c * TOK + t0 + 16 * s + 8 * hi);
            u32x4 w; w.x = pk2(bflo(raw.x) * r0[0], bfhi(raw.x) * r0[1]); w.y = pk2(bflo(raw.y) * r0[2], bfhi(raw.y) * r0[3]);
            w.z = pk2(bflo(raw.z) * r1[0], bfhi(raw.z) * r1[1]); w.w = pk2(bflo(raw.w) * r1[2], bfhi(raw.w) * r1[3]);
            vb[s] = __builtin_bit_cast(bf16x8, w);
        }
        const float gn = sgng[c];
#pragma unroll 1
        for (int pb = 0; pb < 4; ++pb) {
            f32x16 a0;
#pragma unroll
            for (int j = 0; j < 16; ++j) a0[j] = 0.f;
#pragma unroll
            for (int s = 0; s < 8; ++s) {
                const bf16x8 wa = *(const bf16x8*)(Wg + (unsigned)((pb * 32 + r32) * 128 + 16 * s + 8 * hi));
                a0 = MFMA32(wa, vb[s], a0);
            }
            unsigned short uu[16], gg[16]; float bb[16];
#pragma unroll
            for (int j = 0; j < 16; ++j) { const int p = pb * 32 + crow(j, hi); const unsigned tok = (unsigned)t0 + p;
                uu[j] = ACT[tok * (unsigned)LDACT + A_SGU + c]; gg[j] = ACT[tok * (unsigned)LDACT + A_SGG + c]; bb[j] = sgb[g * 128 + p]; }
#pragma unroll
            for (int j = 0; j < 16; ++j) { const int p = pb * 32 + crow(j, hi); const unsigned tok = (unsigned)t0 + p;
                const float sv = a0[j] * gn + bb[j];
                YCAT[tok * (unsigned)LDY + Y_SG + c] = (bf16_t)f2bf(bf2f(uu[j]) * sv * siluf_(bf2f(gg[j]))); }
        }
    }
    __syncthreads();
}

__device__ __forceinline__ void transpose_item(const float* W, int K, int N, bf16_t* WT, int ldt, int item, int lane, LAS float* scr, bool permute) {
    const int nblk = N / 32, kb = item / nblk, nb = item % nblk, k0 = 64 * kb, n0 = 32 * nb;
#pragma unroll 8
    for (int i = 0; i < 32; ++i) { const int kk = 2 * i + (lane >> 5); scr[kk * 33 + (lane & 31)] = W[(size_t)(k0 + kk) * N + n0 + (lane & 31)]; }
    asm volatile("s_waitcnt lgkmcnt(0)" ::: "memory");
    int d0 = n0;
    if (permute) { const int s = n0 >> 9; int ds;
        if (s == 1) ds = 18; else if (s == 5) ds = 19; else if (s == 9) ds = 20; else ds = s - (s > 9 ? 3 : s > 5 ? 2 : s > 1 ? 1 : 0);
        d0 = ds * 512 + (n0 & 511); }
    const int c = lane & 7;
#pragma unroll
    for (int j = 0; j < 4; ++j) { const int n = (lane >> 3) + 8 * j; const LAS float* s = scr + (8 * c) * 33 + n;
        u32x4 o; o.x = pk2(s[0 * 33], s[1 * 33]); o.y = pk2(s[2 * 33], s[3 * 33]); o.z = pk2(s[4 * 33], s[5 * 33]); o.w = pk2(s[6 * 33], s[7 * 33]);
        *(u32x4*)(WT + (size_t)(d0 + n) * ldt + k0 + 8 * c) = o; }
    asm volatile("s_waitcnt lgkmcnt(0)" ::: "memory");
}

__device__ __forceinline__ void convert_layer_weights(int l, LAS unsigned char* lds) {
    KPARAMS;
    const int tid = ltid(), wave = tid >> 6, lane = tid & 63;
    LAS float* scr = (LAS float*)(lds + wave * 16384);
    const int gw = blockIdx.x * 8 + wave, NGW = gridDim.x * 8;
    unsigned char* ws_ = lws(P); bf16_t* WIN = (bf16_t*)(ws_ + WS_WIN); bf16_t* WP = (bf16_t*)(ws_ + WS_WP); bf16_t* WO = (bf16_t*)(ws_ + WS_WO);
    constexpr int I_IN = 16 * 336, I_P = 8 * 32, I_F = 16 * 32, I_O = 16 * 32, NIT = I_IN + 3 * I_P + I_F + I_O;
    for (int it = gw; it < NIT; it += NGW) {
        int r = it;
        if (r < I_IN) { transpose_item(P.in[I_WIN] + (size_t)l * 1024 * NIN, 1024, NIN, WIN, 1024, r, lane, scr, true); continue; } r -= I_IN;
        if (r < I_P) { transpose_item(P.in[I_PSG] + (size_t)l * 512 * 1024, 512, 1024, WP, LDY, r, lane, scr, false); continue; } r -= I_P;
        if (r < I_P) { transpose_item(P.in[I_PDIFF] + (size_t)l * 512 * 1024, 512, 1024, WP + 512, LDY, r, lane, scr, false); continue; } r -= I_P;
        if (r < I_P) { transpose_item(P.in[I_PNA] + (size_t)l * 512 * 1024, 512, 1024, WP + 1024, LDY, r, lane, scr, false); continue; } r -= I_P;
        if (r < I_F) { transpose_item(P.in[I_PFNET] + (size_t)l * 1024 * 1024, 1024, 1024, WP + 1536, LDY, r, lane, scr, false); continue; } r -= I_F;
        transpose_item(P.in[I_WOUT] + (size_t)l * 1024 * 1024, 1024, 1024, WO, 1024, r, lane, scr, false);
    }
}

__device__ __forceinline__ void p1_rows(int l) {
    KPARAMS;
    const int tid = ltid(), wave = tid >> 6, lane = tid & 63;
    const int gw = blockIdx.x * 8 + wave, NGW = gridDim.x * 8;
    const float* MOD = (const float*)(P.ws + WS_MOD);
    const bf16_t* OUTRAW = (const bf16_t*)(P.ws + WS_ACT);
    bf16_t* HB = (bf16_t*)(P.ws + WS_R1);
#pragma unroll 1
    for (int t0 = gw; t0 < TOK; t0 += 2 * NGW) {
        f32x4 x[2][4]; u32x2 rq[2][4];
        int tt[2], cvv[2];
#pragma unroll
        for (int q = 0; q < 2; ++q) { int t = t0 + q * NGW; tt[q] = t; if (t >= TOK) t = t0; cvv[q] = t < TCTX ? 0 : 1 + ((t - TCTX) >> 12);
            const float* xs = (l <= 1) ? (t < TCTX ? P.in[I_XP] + (size_t)t * DM : P.in[I_XS] + (size_t)(t - TCTX) * DM) : P.out + (size_t)t * DM;
#pragma unroll
            for (int j = 0; j < 4; ++j) x[q][j] = *(const f32x4*)(xs + 4 * lane + 256 * j);
            if (l >= 1) {
#pragma unroll
                for (int j = 0; j < 4; ++j) rq[q][j] = *(const u32x2*)(OUTRAW + (size_t)t * DM + 4 * lane + 256 * j); } }
#pragma unroll
        for (int q = 0; q < 2; ++q) { const int t = tt[q], cv = cvv[q];
            if (t >= TOK) continue;
            if (l >= 1) {
                f32x4 r[4]; float s = 0.f;
#pragma unroll
                for (int j = 0; j < 4; ++j) { const u32x2 w = rq[q][j]; r[j] = (f32x4){bflo(w.x), bfhi(w.x), bflo(w.y), bfhi(w.y)}; s += r[j][0] * r[j][0] + r[j][1] * r[j][1] + r[j][2] * r[j][2] + r[j][3] * r[j][3]; }
                const float rs = rsqrtf(wave_sum(s) * (1.0f / DM) + EPSN);
                const float* gate = MOD + ((size_t)(l - 1) * 3 + cv) * 3072 + 2048;
                const float* gp = P.in[I_GPOST] + (size_t)(l - 1) * DM;
#pragma unroll
                for (int j = 0; j < 4; ++j) { const f32x4 gt = *(const f32x4*)(gate + 4 * lane + 256 * j), gg = *(const f32x4*)(gp + 4 * lane + 256 * j);
                    x[q][j] = x[q][j] + gt * (r[j] * rs * gg);
                    *(f32x4*)(P.out + (size_t)t * DM + 4 * lane + 256 * j) = x[q][j]; }
            }
            if (l < 4) {
                float s = 0.f;
#pragma unroll
                for (int j = 0; j < 4; ++j) s += x[q][j][0] * x[q][j][0] + x[q][j][1] * x[q][j][1] + x[q][j][2] * x[q][j][2] + x[q][j][3] * x[q][j][3];
                const float rs = rsqrtf(wave_sum(s) * (1.0f / DM) + EPSN);
                const float* md = MOD + ((size_t)l * 3 + cv) * 3072;
                const float* gp = P.in[I_GPRE] + (size_t)l * DM;
#pragma unroll
                for (int j = 0; j < 4; ++j) { const int c = 4 * lane + 256 * j;
                    const f32x4 sh = *(const f32x4*)(md + c), sc = *(const f32x4*)(md + 1024 + c), gg = *(const f32x4*)(gp + c);
                    const f32x4 hh = x[q][j] * rs * gg * (sc + 1.0f) + sh;
                    u32x2 w; w.x = pk2(hh[0], hh[1]); w.y = pk2(hh[2], hh[3]);
                    *(u32x2*)(HB + (size_t)t * DM + c) = w; }
            }
        }
    }
}

__device__ __forceinline__ void prologue(LAS unsigned char* lds) {
    KPARAMS;
    const int tid = ltid(), wave = tid >> 6, lane = tid & 63;
    const size_t gt = (size_t)blockIdx.x * NTHR + tid, GT = (size_t)gridDim.x * NTHR;
    LAS float* tab = (LAS float*)lds;
    for (int k = tid; k < 4096; k += NTHR) tab[k] = cosf((float)k * (6.283185307179586f / 4096.0f)) * (1.0f / 64.0f);
    __syncthreads();
    {
        bf16_t* CSL = (bf16_t*)(P.ws + WS_CSL);
        for (size_t e = gt; e < (size_t)4096 * 512; e += GT) { const int i = (int)(e >> 9), j0 = (int)(e & 511) * 8;
            u32x4 wc, ws; unsigned* pc = (unsigned*)&wc; unsigned* ps = (unsigned*)&ws;
#pragma unroll
            for (int q = 0; q < 4; ++q) { const int i0 = (i * (j0 + 2 * q)) & 4095, i1 = (i * (j0 + 2 * q + 1)) & 4095;
                pc[q] = pk2(tab[i0], tab[i1]); ps[q] = pk2(tab[(i0 + 1024) & 4095], tab[(i1 + 1024) & 4095]); }
            *(u32x4*)(CSL + (size_t)i * 8192 + j0) = wc; *(u32x4*)(CSL + (size_t)i * 8192 + 4096 + j0) = ws; }
        bf16_t* CS256 = (bf16_t*)(P.ws + WS_CS256); bf16_t* CSP = (bf16_t*)(P.ws + WS_CSP256);
        for (size_t e = gt; e < 256 * 256; e += GT) { const int j = (int)(e >> 8), k = (int)(e & 255); const int idx = ((j * k) & 255) * 16;
            const float cv = tab[idx] * 4.0f, sv = tab[(idx + 3072) & 4095] * 4.0f;
            CS256[j * 256 + k] = (bf16_t)f2bf(cv); CS256[(256 + j) * 256 + k] = (bf16_t)f2bf(sv);
            CSP[j * 512 + k] = (bf16_t)f2bf(cv); CSP[j * 512 + 256 + k] = (bf16_t)f2bf(-sv); }
    }
    {
        float* ROPE = (float*)(P.ws + WS_ROPE);
        for (size_t e = gt; e < 64 * 16; e += GT) { const int pos = (int)(e >> 4), f = (int)(e & 15);
            const float inv = powf(10000.0f, -(float)f / 16.0f); const float ang = (float)pos * inv;
            ROPE[pos * 32 + f] = cosf(ang); ROPE[pos * 32 + 16 + f] = sinf(ang); }
        float* RPB = (float*)(P.ws + WS_RPB);
        for (size_t e = gt; e < 4 * 8 * 15 * 31; e += GT) RPB[e] = P.in[I_RPB][e] * LOG2E;
        bf16_t* SGW = (bf16_t*)(P.ws + WS_SGW);
        for (size_t e = gt; e < 4 * 8 * 128 * 128; e += GT) SGW[e] = (bf16_t)f2bf(P.in[I_SGW][e]);
    }
    {
        bf16_t* CDK = (bf16_t*)(P.ws + WS_CDK); bf16_t* CNK = (bf16_t*)(P.ws + WS_CNK);
        bf16_t* CDVT = (bf16_t*)(P.ws + WS_CDVT); bf16_t* CNVT = (bf16_t*)(P.ws + WS_CNVT);
        const size_t NC4 = (size_t)2 * 4 * 512 * 512 / 4;
        for (size_t e = gt; e < NC4; e += GT) { const f32x4 a = *(const f32x4*)(P.in[I_CDK] + 4 * e), b = *(const f32x4*)(P.in[I_CNK] + 4 * e);
            u32x2 wa, wb; wa.x = pk2(a[0], a[1]); wa.y = pk2(a[2], a[3]); wb.x = pk2(b[0], b[1]); wb.y = pk2(b[2], b[3]);
            *(u32x2*)(CDK + 4 * e) = wa; *(u32x2*)(CNK + 4 * e) = wb; }
        LAS float* tl = (LAS float*)(lds + 32768);
        const int ti = tid >> 6, tj = tid & 63;
        for (int tile = blockIdx.x; tile < 1024; tile += gridDim.x) {
            const int arr = tile >> 9, r = tile & 511, bl = r >> 6, pb = (r >> 3) & 7, fb = r & 7;
            const float* src = (arr ? P.in[I_CNV] : P.in[I_CDV]) + ((size_t)(bl * 512 + pb * 64) * 512 + fb * 64);
#pragma unroll
            for (int rr = 0; rr < 8; ++rr) { const int p = rr * 8 + ti; tl[p * 65 + tj] = src[(size_t)p * 512 + tj]; }
            __syncthreads();
            bf16_t* dst = (arr ? CNVT : CDVT) + ((size_t)(bl * 512 + fb * 64) * 512 + pb * 64);
#pragma unroll
            for (int rr = 0; rr < 8; ++rr) { const int f = rr * 8 + ti; dst[(size_t)f * 512 + tj] = (bf16_t)f2bf(tl[tj * 65 + f]); }
            __syncthreads();
        }
    }
    __syncthreads();
    {
        float* MOD = (float*)(P.ws + WS_MOD);
        LAS float* red = (LAS float*)lds;
        LAS float* sc = (LAS float*)(lds + 16384);
        for (int k = tid; k < 1024; k += NTHR) { sc[k] = siluf_(P.in[I_CCTX][k]); sc[1024 + k] = siluf_(P.in[I_C][k]); sc[2048 + k] = siluf_(P.in[I_C][1024 + k]); }
        __syncthreads();
        for (int un = blockIdx.x; un < 4 * 48; un += gridDim.x) {
            const int l = un / 48, jb = un % 48; const int j = jb * 64 + lane;
            const float* w = P.in[I_WMOD] + (size_t)l * 1024 * 3072 + j;
            float a0 = 0.f, a1 = 0.f, a2 = 0.f;
#pragma unroll 1
            for (int k0 = wave * 128; k0 < wave * 128 + 128; k0 += 16) {
                float wv[16];
#pragma unroll
                for (int i = 0; i < 16; ++i) wv[i] = w[(size_t)(k0 + i) * 3072];
#pragma unroll
                for (int i = 0; i < 16; ++i) { a0 += sc[k0 + i] * wv[i]; a1 += sc[1024 + k0 + i] * wv[i]; a2 += sc[2048 + k0 + i] * wv[i]; }
            }
            red[(wave * 3 + 0) * 64 + lane] = a0; red[(wave * 3 + 1) * 64 + lane] = a1; red[(wave * 3 + 2) * 64 + lane] = a2;
            __syncthreads();
            if (tid < 192) { const int cv = tid >> 6, ln = tid & 63; float sm = 0.f;
#pragma unroll
                for (int w8 = 0; w8 < 8; ++w8) sm += red[(w8 * 3 + cv) * 64 + ln];
                MOD[((size_t)l * 3 + cv) * 3072 + jb * 64 + ln] = sm + P.in[I_BMOD][(size_t)l * 3072 + jb * 64 + ln]; }
            __syncthreads();
        }
    }
}

__device__ __forceinline__ void combine_pf() {
    KPARAMS;
    const float* PF = (const float*)(P.ws + WS_R1); const bf16_t* ACT = (const bf16_t*)(P.ws + WS_ACT); bf16_t* YCAT = (bf16_t*)(P.ws + WS_YCAT);
    const size_t gt = (size_t)blockIdx.x * NTHR + ltid(), GT = (size_t)gridDim.x * NTHR;
    for (size_t e = gt; e < (size_t)8192 * 256; e += GT) { const size_t t = e >> 8; const int c = (int)(e & 255) * 4;
        const f32x4 a = *(const f32x4*)(PF + t * 1024 + c), b = *(const f32x4*)(PF + (size_t)8192 * 1024 + t * 1024 + c);
        const size_t tok = TCTX + t;
        const u32x2 g = *(const u32x2*)(ACT + tok * LDACT + A_FG + c);
        u32x2 w; w.x = pk2((a[0] + b[0]) * bflo(g.x), (a[1] + b[1]) * bfhi(g.x)); w.y = pk2((a[2] + b[2]) * bflo(g.y), (a[3] + b[3]) * bfhi(g.y));
        *(u32x2*)(YCAT + tok * LDY + Y_F + c) = w; }
}

constexpr size_t WS_BAR = WS_SMALL + 2 * MiB + 512 * 1024;
constexpr int LDS_BARST = LDS_BYTES - 64;
#define XB_TMO      128
#define XB_XCNT(j)  (256  + 64 * (j))
#define XB_XSUB(j)  (1280 + 64 * (j))
#define XB_XGEN(j)  (2304 + 64 * (j))
#define XB_TOP      3328
#define XB_TOPGEN   3392
#define XCD_BAR_WORDS 3456
#define XB_SPIN_CAP (1u << 20)
__device__ __forceinline__ unsigned xb_ld(unsigned* p)              { return __hip_atomic_load(p, __ATOMIC_RELAXED, __HIP_MEMORY_SCOPE_AGENT); }
__device__ __forceinline__ unsigned xb_add(unsigned* p, unsigned v) { return __hip_atomic_fetch_add(p, v, __ATOMIC_RELAXED, __HIP_MEMORY_SCOPE_AGENT); }
__device__ __forceinline__ unsigned xb_xcc_id() { return (unsigned)__builtin_amdgcn_s_getreg((3 << 11) | 20) & 0xFu; }
#define XB_SPIN(cond, bar) do { unsigned _sp = 0; while (cond) { __builtin_amdgcn_s_sleep(1); \
    if ((++_sp & 255u) == 0u) { if (xb_ld(&(bar)[XB_TMO])) break; if (_sp > XB_SPIN_CAP) { atomicAdd(&(bar)[XB_TMO], 1u); break; } } } } while (0)
__device__ __forceinline__ void xcd_barrier_complete(unsigned* bar, unsigned x, unsigned& nloc, unsigned& nx) {
    const unsigned G = gridDim.x;
    unsigned sum, cnt, mine, sp = 0u;
    for (;;) {
        sum = 0u; cnt = 0u; mine = 0u;
#pragma unroll
        for (unsigned j = 0; j < 16; ++j) { const unsigned c = xb_ld(&bar[XB_XCNT(j)]); sum += c; cnt += (c > 0u) ? 1u : 0u; mine = (j == x) ? c : mine; }
        if (sum == G) break;
        __builtin_amdgcn_s_sleep(1);
        if ((++sp & 255u) == 0u) { if (xb_ld(&bar[XB_TMO])) break; if (sp > XB_SPIN_CAP) { atomicAdd(&bar[XB_TMO], 1u); break; } }
    }
    nloc = mine > 0u ? mine : 1u; nx = cnt > 0u ? cnt : 1u;
}
__device__ __forceinline__ void gbar(LAS unsigned char* lds) {
    KPARAMS;
    asm volatile("s_waitcnt vmcnt(0)" ::: "memory");
    __syncthreads();
    if (threadIdx.x == 0) {
        unsigned* bar = (unsigned*)(lws(P) + WS_BAR);
        volatile LAS unsigned* st = (volatile LAS unsigned*)(lds + LDS_BARST);
        const unsigned x = xb_xcc_id();
        __builtin_amdgcn_s_waitcnt(0);
        unsigned nloc = st[0], nx = st[1];
        if (nloc == 0u) { xcd_barrier_complete(bar, x, nloc, nx); st[0] = nloc; st[1] = nx; }
        const unsigned old = xb_add(&bar[XB_XSUB(x)], 1u);
        const unsigned gen = old / nloc;
        if (old + 1u == (gen + 1u) * nloc) {
            __builtin_amdgcn_fence(__ATOMIC_RELEASE, "agent");
            asm volatile("s_waitcnt vmcnt(0)" ::: "memory");
            const unsigned og = xb_add(&bar[XB_TOP], 1u);
            const unsigned tg = og / nx;
            if (og + 1u == (tg + 1u) * nx) xb_add(&bar[XB_TOPGEN], 1u);
            else XB_SPIN(xb_ld(&bar[XB_TOPGEN]) == tg, bar);
            __builtin_amdgcn_fence(__ATOMIC_ACQUIRE, "agent");
            xb_add(&bar[XB_XGEN(x)], 1u);
            asm volatile("s_waitcnt vmcnt(0)" ::: "memory");
        } else {
            XB_SPIN(xb_ld(&bar[XB_XGEN(x)]) == gen, bar);
            __builtin_amdgcn_fence(__ATOMIC_ACQUIRE, "agent");
            asm volatile("s_waitcnt vmcnt(0)" ::: "memory");
        }
    }
    __syncthreads();
}

#ifndef REP_P2
#define REP_P2 1
#endif
#ifndef REP_DFT
#define REP_DFT 1
#endif
#ifndef REP_DL
#define REP_DL 1
#endif
#ifndef REP_AR
#define REP_AR 1
#endif
#ifndef REP_P4
#define REP_P4 1
#endif
#ifndef REP_P5
#define REP_P5 1
#endif
#ifndef REP_CONV
#define REP_CONV 1
#endif

struct EpiC { static constexpr bool HOOK = false; EpiCdft e; __device__ __forceinline__ void operator()(EPI_ARGS) const { Unit v = u; v.pm = u.x * 2 + u.pm; e(acc, v, wr, wc, fr, fq); } };
__device__ __forceinline__ void phase2(int l, LAS unsigned char* lds) {
    KPARAMS;
    unsigned char* ws = lws(P); const int G = gridDim.x, bid = lbid();
    bf16_t* WIN = (bf16_t*)(ws + WS_WIN); bf16_t* HB = (bf16_t*)(ws + WS_R1); bf16_t* ACT = (bf16_t*)(ws + WS_ACT); bf16_t* XT = (bf16_t*)(ws + WS_R3);
#pragma unroll 1
    for (int step = 0; step < 3; ++step) {
        const int which = (bid >= (G >> 1)) ? (step == 0 ? 2 : step - 1) : step;
        if (which == 0) {
            Job J{HB, WIN, 1024, 1024, 1024, 64, 36, 1, G, bid, 256L * 1024, 0, 0, 0, 256L * 1024, 0, 1};
            EpiIn E{ACT, P.out + (size_t)1 * 16777216, P.out + (size_t)3 * 16777216, (const float*)(ws + WS_ROPE), l, (bf16_t*)(ws + WS_GF)};
            pg8::gemm_phase(lds, J, E);
        } else if (which == 1) {
            Job J{WIN + (size_t)9216 * 1024, HB, 1024, 1024, 1024, 6, 64, 1, G, bid, 256L * 1024, 0, 0, 0, 256L * 1024, 0, 0};
            EpiInT E{XT, P.out + (size_t)2 * 16777216, P.out + (size_t)4 * 16777216, l};
            pg8::gemm_phase(lds, J, E);
        } else {
            const int hG = G >> 1;
            if (bid >= hG) {
            Job J{(const bf16_t*)(ws + WS_CS256), HB, 256, 1024, 256, 2, 64, 4, hG, bid - hG, 256L * 256, 0, 0, 0, 256L * 1024, 256, 0};
            EpiC E{{(bf16_t*)(ws + WS_R2), (bf16_t*)(ws + WS_R2 + 32 * MiB)}};
            pg8::gemm_phase(lds, J, E);
            }
        }
    }
}

__device__ __forceinline__ void phase3_dft(int l, LAS unsigned char* lds) {
    KPARAMS;
    unsigned char* ws = lws(P); const int G = gridDim.x, bid = lbid(), hG = G >> 1;
    if (bid < hG) {
        Job J{(const bf16_t*)(ws + WS_CSL), (const bf16_t*)(ws + WS_R2 + 32 * MiB), 8192, 8192, 8192, 16, 4, 2, hG, bid, 256L * 8192, 0, 0, 0, 256L * 8192, 1024L * 8192, 0};
        EpiPdftCtx E{(const bf16_t*)(ws + WS_GF), (bf16_t*)(ws + WS_YCAT), TCTX, 4096};
        pg8::gemm_phase(lds, J, E);
    } else {
        Job J{(const bf16_t*)(ws + WS_CSP256), (const bf16_t*)(ws + WS_R2), 512, 512, 512, 1, 4, 32, G - hG, bid - hG, 0, 0, 0, 0, 256L * 512, 1024L * 512, 0};
        EpiPdftCtx E{(const bf16_t*)(ws + WS_GF), (bf16_t*)(ws + WS_YCAT), 0, 256};
        pg8::gemm_phase(lds, J, E);
    }
}

__device__ __forceinline__ void na_unit(int l, int id, LAS unsigned char* lds) {
    KPARAMS;
    unsigned char* ws = lws(P);
    const bf16_t* ACT = (const bf16_t*)(ws + WS_ACT); const bf16_t* XT = (const bf16_t*)(ws + WS_R3); bf16_t* YCAT = (bf16_t*)(ws + WS_YCAT);
    const int tid = ltid(), wid = __builtin_amdgcn_readfirstlane(tid >> 6), lane = tid & 63, r32 = lane & 31, hi = lane >> 5;
        const int xc = id & 7, jj = id >> 3, b = xc >> 2, hg = (xc >> 1) & 1, r = (xc & 1) * 32 + jj;
        const int r0 = min(max(r - 4, 0), 56);
        const size_t base = TCTX + (size_t)b * 4096;
        KVSrc S{ACT + (base + (size_t)r0 * 64) * LDACT + A_NK + hg * 256, LDACT, XT + (size_t)(1024 + hg * 256) * TOK + base + (size_t)r0 * 64, TOK, 8,
                (const bf16_t*)(ws + WS_CNK) + ((size_t)(b * 4 + l) * 512) * 512 + hg * 256, 512, (const bf16_t*)(ws + WS_CNVT) + ((size_t)(b * 4 + l) * 512 + hg * 256) * 512, 512};
        const int hl = wid >> 1, qh = wid & 1, h = hg * 4 + hl, qc = qh * 32 + r32;
        const size_t tok = base + (size_t)r * 64 + qc;
        f32x16 o[2]; float lsum;
        LAS float* rpbl = (LAS float*)(lds + 141312);
        { const float* rsrc = (const float*)(ws + WS_RPB) + (size_t)(l * 8 + hg * 4) * 15 * 31;
          for (int i = tid; i < 4 * 15 * 31; i += NTHR) rpbl[i] = rsrc[i]; }
        attn_core<64, 256, 2>(lds, ACT + tok * LDACT + A_NQ + h * 64, S, 16, hl * 64, hl * 64, rpbl + hl * 15 * 31, r0 - r, qc, o, lsum);
        attn_store64(o, lsum, ACT + tok * LDACT + A_NG + h * 64, YCAT + tok * LDY + Y_NA + h * 64, hi);
}

__device__ __forceinline__ void phase3_attn_a(int l, LAS unsigned char* lds) {
    KPARAMS;
    unsigned char* ws = lws(P); const int G = gridDim.x, bid = lbid();
    const bf16_t* ACT = (const bf16_t*)(ws + WS_ACT); const bf16_t* XT = (const bf16_t*)(ws + WS_R3); bf16_t* YCAT = (bf16_t*)(ws + WS_YCAT);
    const int tid = ltid(), wid = __builtin_amdgcn_readfirstlane(tid >> 6), lane = tid & 63, r32 = lane & 31, hi = lane >> 5;
    const float lam_init = 0.8f - 0.6f * expf(-0.3f * (float)l);
    const float d1 = wave_sum(P.in[I_LQ1][l * 64 + lane] * P.in[I_LK1][l * 64 + lane]);
    const float d2 = wave_sum(P.in[I_LQ2][l * 64 + lane] * P.in[I_LK2][l * 64 + lane]);
    const float lam = expf(d1) - expf(d2) + lam_init;
    const float* subln = P.in[I_SUBLN] + l * 128;
#pragma unroll 1
    for (int rp = 0; rp < REP_AR; ++rp) {
    if (bid >= (G >> 1)) {
#pragma unroll 1
        for (int id = bid - (G >> 1); id < 256; id += G - (G >> 1)) na_unit(l, id, lds);
    }
    for (int id = bid; id < 256; id += G) {
        const int b = id >> 3, h = (id >> 1) & 3, qh = id & 1;
        const size_t base = (size_t)b * 256;
        KVSrc S{ACT + base * LDACT + A_DK + h * 128, LDACT, XT + (size_t)(512 + h * 128) * TOK + base, TOK, 4, nullptr, 0, nullptr, 0};
        diff_unit(lds, ACT, YCAT, S, 4, base + (size_t)qh * 128, h, lam, lam_init, subln);
    }
    for (int id = bid; id < 256; id += G) {
        const int b = id >> 3, h = id & 7;
        const size_t base = (size_t)b * 256;
        KVSrc S{ACT + base * LDACT + A_NK + h * 64, LDACT, XT + (size_t)(1024 + h * 64) * TOK + base, TOK, 4, nullptr, 0, nullptr, 0};
        const size_t tok = base + wid * 32 + r32;
        f32x16 o[2]; float lsum;
        attn_core<64, 64, 0>(lds, ACT + tok * LDACT + A_NQ + h * 64, S, 4, 0, 0, nullptr, 0, 0, o, lsum);
        attn_store64(o, lsum, ACT + tok * LDACT + A_NG + h * 64, YCAT + tok * LDY + Y_NA + h * 64, hi);
    }
    for (int id = G - 1 - bid; id < 128; id += G)
        spatial_unit(lds, id, ACT, XT, (const bf16_t*)(ws + WS_SGW) + (size_t)l * 8 * 128 * 128, P.in[I_SGB] + l * 1024, P.in[I_SGNG] + l * 512, YCAT);
    }
}

__device__ __forceinline__ void phase3_attn_b(int l, LAS unsigned char* lds) {
    KPARAMS;
    unsigned char* ws = lws(P); const int G = gridDim.x, bid = lbid();
    const bf16_t* ACT = (const bf16_t*)(ws + WS_ACT); const bf16_t* XT = (const bf16_t*)(ws + WS_R3); bf16_t* YCAT = (bf16_t*)(ws + WS_YCAT);
    const int tid = ltid(), wid = __builtin_amdgcn_readfirstlane(tid >> 6), lane = tid & 63, r32 = lane & 31, hi = lane >> 5;
    const float lam_init = 0.8f - 0.6f * expf(-0.3f * (float)l);
    const float d1 = wave_sum(P.in[I_LQ1][l * 64 + lane] * P.in[I_LK1][l * 64 + lane]);
    const float d2 = wave_sum(P.in[I_LQ2][l * 64 + lane] * P.in[I_LK2][l * 64 + lane]);
    const float lam = expf(d1) - expf(d2) + lam_init;
    const float* subln = P.in[I_SUBLN] + l * 128;
#pragma unroll 1
    for (int rp = 0; rp < REP_DL; ++rp)
    for (int id = bid; id < 256; id += G) {
        const int bh = id & 7, qb = id >> 3, b = bh >> 2, h = bh & 3;
        const size_t base = TCTX + (size_t)b * 4096;
        KVSrc S{ACT + base * LDACT + A_DK + h * 128, LDACT, XT + (size_t)(512 + h * 128) * TOK + base, TOK, 64,
                (const bf16_t*)(ws + WS_CDK) + ((size_t)(b * 4 + l) * 512) * 512 + h * 128, 512, (const bf16_t*)(ws + WS_CDVT) + ((size_t)(b * 4 + l) * 512 + h * 128) * 512, 512};
        diff_unit(lds, ACT, YCAT, S, 72, base + (size_t)qb * 128, h, lam, lam_init, subln);
    }
}

__device__ __forceinline__ void phase_mix(LAS unsigned char* lds) {
    KPARAMS;
    unsigned char* ws = lws(P); const int G = gridDim.x, bid = lbid();
    Job J{(const bf16_t*)(ws + WS_YCAT), (const bf16_t*)(ws + WS_WP), LDY, LDY, LDY, 64, 4, 1, G, bid, 256L * LDY, 0, 0, 0, 256L * LDY, 0, 1};
    EpiMix E{(const bf16_t*)(ws + WS_GF), (bf16_t*)(ws + WS_R3)};
    pg8::gemm_phase(lds, J, E);
}

__device__ __forceinline__ void phase5(LAS unsigned char* lds) {
    KPARAMS;
    unsigned char* ws = lws(P); const int G = gridDim.x, bid = lbid();
    Job J{(const bf16_t*)(ws + WS_R3), (const bf16_t*)(ws + WS_WO), 1024, 1024, 1024, 64, 4, 1, G, bid, 256L * 1024, 0, 0, 0, 256L * 1024, 0, 1};
    EpiOut E{(bf16_t*)(ws + WS_ACT)};
    pg8::gemm_phase(lds, J, E);
}

__global__ void __launch_bounds__(NTHR, 2) fwd_megakernel(Params P) {
    extern __shared__ __attribute__((aligned(16))) unsigned char smem[];
    LAS unsigned char* lds = (LAS unsigned char*)smem;
    cg::grid_group grid = cg::this_grid();
    if (threadIdx.x < 16) ((LAS unsigned*)(lds + LDS_BARST))[threadIdx.x] = 0u;
    if (blockIdx.x == 0) { unsigned* bar = (unsigned*)(P.ws + WS_BAR); for (int i = threadIdx.x; i < XCD_BAR_WORDS; i += NTHR) __hip_atomic_store(bar + i, 0u, __ATOMIC_RELAXED, __HIP_MEMORY_SCOPE_AGENT); }
    prologue(lds);
    grid.sync();
    if (threadIdx.x == 0) (void)xb_add((unsigned*)(P.ws + WS_BAR) + XB_XCNT(xb_xcc_id()), 1u);
#pragma unroll 1
    for (int l = 0; l < 4; ++l) {
#pragma unroll 1
        for (int rp = 0; rp < REP_CONV; ++rp) convert_layer_weights(l, lds);
        p1_rows(l);
        gbar(lds);
#pragma unroll 1
        for (int rp = 0; rp < REP_P2; ++rp) phase2(l, lds);
        gbar(lds);
#pragma unroll 1
        for (int rp = 0; rp < REP_DFT; ++rp) phase3_dft(l, lds);
        phase3_attn_a(l, lds);
        phase3_attn_b(l, lds);
        gbar(lds);
#pragma unroll 1
        for (int rp = 0; rp < REP_P4; ++rp) {
        if (rp) gbar(lds);
        phase_mix(lds);
        gbar(lds);
        }
#pragma unroll 1
        for (int rp = 0; rp < REP_P5; ++rp) phase5(lds);
        gbar(lds);
    }
    p1_rows(4);
}

extern "C" void kernel_launch(void* const* d_in, const int* in_sizes, int n_in, void* d_out, int out_size, void* d_ws, size_t ws_size, hipStream_t stream) {
    static int grid = 0;
    if (grid == 0) {
        if (n_in != 27 || ws_size < WS_END) { fprintf(stderr, "kernel_launch: unexpected n_in %d or ws_size %zu (< %zu)\n", n_in, ws_size, (size_t)WS_END); grid = -1; return; }
        int dev = 0, cus = 0, per_cu = 0;
        hipGetDevice(&dev);
        hipDeviceGetAttribute(&cus, hipDeviceAttributeMultiprocessorCount, dev);
        hipFuncSetAttribute((const void*)fwd_megakernel, hipFuncAttributeMaxDynamicSharedMemorySize, LDS_BYTES);
        hipOccupancyMaxActiveBlocksPerMultiprocessor(&per_cu, (const void*)fwd_megakernel, NTHR, LDS_BYTES);
        if (per_cu < 1) { fprintf(stderr, "kernel_launch: occupancy query says %d blocks/CU\n", per_cu); per_cu = 1; }
        (void)hipGetLastError();
        grid = cus;
    }
    if (grid < 0) return;
    Params p{};
    for (int i = 0; i < 27; ++i) p.in[i] = (const float*)d_in[i];
    p.out = (float*)d_out; p.ws = (unsigned char*)d_ws;
    void* args[] = {&p};
    hipError_t e = hipLaunchCooperativeKernel((const void*)fwd_megakernel, dim3(grid), dim3(NTHR), args, LDS_BYTES, stream);
    if (e != hipSuccess) fprintf(stderr, "cooperative launch failed: %s (grid %d)\n", hipGetErrorString(e), grid);
}
```

```cpp
#include <hip/hip_runtime.h>
#include <hip/hip_cooperative_groups.h>
#include <cstdio>
#include <cstdint>
namespace cg = cooperative_groups;

#define LAS __attribute__((address_space(3)))
typedef unsigned short bf16_t;
typedef short bf16x8 __attribute__((ext_vector_type(8)));
typedef short s16x4 __attribute__((ext_vector_type(4)));
typedef float f32x4 __attribute__((ext_vector_type(4)));
typedef float f32x16 __attribute__((ext_vector_type(16)));
typedef unsigned u32x4 __attribute__((ext_vector_type(4)));
typedef unsigned u32x2 __attribute__((ext_vector_type(2)));

constexpr int DM = 1024, TOK = 16384, TCTX = 8192, NIN = 10752, LDACT = 4160, LDY = 2560;
constexpr int GF_TILES = 20, GF_TILE = 65536;
constexpr int A_SGU = 0, A_SGG = 512, A_DQ = 1024, A_DK = 1536, A_DG = 2048, A_NQ = 2560, A_NK = 3072, A_NG = 3584, A_FG = 4096, A_MG = 5120;
constexpr int Y_SG = 0, Y_D = 512, Y_NA = 1024, Y_F = 1536;
constexpr float EPSN = 1e-6f;
constexpr float QSCALE = 0.125f * 1.4426950408889634f;
constexpr float LOG2E = 1.4426950408889634f;
constexpr int NTHR = 512;
constexpr int LDS_BYTES = 155648;

constexpr size_t MiB = 1u << 20;
constexpr size_t WS_WIN = 0;
constexpr size_t WS_WP = 21 * MiB;
constexpr size_t WS_WO = 26 * MiB;
constexpr size_t WS_CSL = 28 * MiB;
constexpr size_t WS_CDK = 92 * MiB, WS_CDVT = 96 * MiB, WS_CNK = 100 * MiB, WS_CNVT = 104 * MiB;
constexpr size_t WS_SMALL = 108 * MiB;
constexpr size_t WS_CS256 = WS_SMALL, WS_CSP256 = WS_SMALL + 256 * 1024, WS_ROPE = WS_SMALL + 512 * 1024, WS_RPB = WS_SMALL + 576 * 1024,
                 WS_MOD = WS_SMALL + 704 * 1024, WS_SGW = WS_SMALL + 1 * MiB;
constexpr size_t WS_ACT = 112 * MiB;
constexpr size_t WS_GF = WS_ACT + 132 * MiB;
constexpr size_t WS_R1 = 432 * MiB;
constexpr size_t WS_R2 = 464 * MiB;
constexpr size_t WS_R3 = 528 * MiB;
constexpr size_t WS_YCAT = 576 * MiB;
constexpr size_t WS_END = 656 * MiB;

struct Params {
    const float* in[27];
    float* out;
    unsigned char* ws;
};
typedef const __attribute__((address_space(4))) Params* KP;
enum { I_XP = 0, I_XS, I_CDK, I_CDV, I_CNK, I_CNV, I_C, I_CCTX, I_WMOD, I_BMOD, I_GPRE, I_GPOST, I_WIN, I_SGNG, I_SGW, I_SGB,
       I_LQ1, I_LK1, I_LQ2, I_LK2, I_SUBLN, I_RPB, I_PSG, I_PDIFF, I_PNA, I_PFNET, I_WOUT };

__device__ __forceinline__ unsigned f2bf(float f) { unsigned u = __builtin_bit_cast(unsigned, f); return (u + 0x7fffu + ((u >> 16) & 1u)) >> 16; }
typedef float f32x2_t __attribute__((ext_vector_type(2))); typedef __bf16 bf16x2_t __attribute__((ext_vector_type(2)));
__device__ __forceinline__ unsigned pk2(float lo, float hi) { f32x2_t v = {lo, hi}; bf16x2_t b = __builtin_convertvector(v, bf16x2_t); return __builtin_bit_cast(unsigned, b); }
__device__ __forceinline__ float bf2f(unsigned short b) { return __builtin_bit_cast(float, (unsigned)b << 16); }
__device__ __forceinline__ float bflo(unsigned w) { return __builtin_bit_cast(float, w << 16); }
__device__ __forceinline__ float bfhi(unsigned w) { return __builtin_bit_cast(float, w & 0xffff0000u); }
__device__ __forceinline__ float wave_sum(float v) {
#pragma unroll
    for (int o = 1; o < 64; o <<= 1) v += __shfl_xor(v, o);
    return v;
}
constexpr float LOG2E_ = 1.4426950408889634f;
__device__ __forceinline__ float fexp2(float x) { return __builtin_amdgcn_exp2f(x); }
__device__ __forceinline__ float sigmoidf_(float x) { return __builtin_amdgcn_rcpf(1.0f + __builtin_amdgcn_exp2f(-LOG2E_ * x)); }
__device__ __forceinline__ float einvsig_(float x) { return 1.0f + __builtin_amdgcn_exp2f(-LOG2E_ * x); }
__device__ __forceinline__ float siluf_(float x) { return x * __builtin_amdgcn_rcpf(1.0f + __builtin_amdgcn_exp2f(-LOG2E_ * x)); }
__device__ __forceinline__ int ltid() { int t = threadIdx.x; asm volatile("" : "+v"(t)); return t; }
#if defined(__HIP_DEVICE_COMPILE__)
__device__ __forceinline__ KP kparams() { KP p = (KP)__builtin_amdgcn_kernarg_segment_ptr(); asm volatile("" : "+s"(p)); return p; }
#endif
#if defined(__HIP_DEVICE_COMPILE__)
#define KPARAMS const KP PP = kparams(); const Params P = *PP
#else
#define KPARAMS const Params P{}
#endif
__device__ __forceinline__ unsigned char* lws(const Params& P) { unsigned char* w = P.ws; asm volatile("" : "+s"(w)); return w; }
__device__ __forceinline__ int lbid() { int b = blockIdx.x; asm volatile("" : "+s"(b)); return b; }
__device__ __forceinline__ unsigned gf_off(int wr, int wc, int ai, int m, int bj, int lane) { return (((((unsigned)(wr * 4 + wc) * 2 + ai) * 4 + m) * 2 + bj) * 64 + lane) * 8u; }
__device__ __forceinline__ int crow(int r, int hi) { return (r & 3) + 8 * (r >> 2) + 4 * hi; }

namespace pg8 {
constexpr int BM = 256, BK = 64, HALF = 128, HTB = HALF * BK * 2, STAGE_BYTES = 8 * HTB;
__device__ __forceinline__ int lds_byte(int r, int c) { const int st = (r >> 4) * 2 + (c >> 5), rr = r & 15, cc = c & 31, ob = rr * 64 + cc * 2; return st * 1024 + (ob ^ (((ob >> 9) & 1) << 5)); }
__device__ __forceinline__ int perm32(int rho) { const int n = rho >> 4, i = rho & 15; return 8 * (i >> 2) + 4 * n + (i & 3); }
__device__ __forceinline__ void stage_rc(int b, int& R, int& C) { const int st = b / 1024, sb = b % 1024, swz = sb ^ (((sb >> 9) & 1) << 5); R = (st >> 1) * 16 + swz / 64; C = (st & 1) * 32 + (swz % 64) / 2; }
struct Unit { int pm, pn, x; };

template <class Job, class Epi>
__device__ __forceinline__ void gemm_phase(LAS unsigned char* lds, const Job& J, const Epi& E) {
    const int tid = ltid(), wid = __builtin_amdgcn_readfirstlane(tid >> 6), lane = tid & 63, wr = wid >> 2, wc = wid & 3, fr = lane & 15, fq = lane >> 4;
    const int K = J.K, nt = K / BK;
    unsigned voffA[2], voffB[2];
#pragma unroll
    for (int i = 0; i < 2; ++i) { int R, C; stage_rc(tid * 16 + i * 8192, R, C);
        const int Rb = (R & ~31) + perm32(R & 31);
        voffA[i] = (unsigned)(R * J.lda + C) * 2u; voffB[i] = (unsigned)(Rb * J.ldb + C) * 2u; }
    const size_t kstep = (size_t)(BK * 2);
    const size_t hstepA = (size_t)HALF * J.lda * 2, hstepB = (size_t)HALF * J.ldb * 2;
    const unsigned ldsw = (unsigned)wid * 1024u;
    const int aoff = lds_byte(wr * 64 + fr, fq * 8), boff = lds_byte(wc * 32 + fr, fq * 8);
#define PG8_SA(b, h) (((b) * 2 + (h)) * HTB)
#define PG8_SB(b, h) ((4 + (b) * 2 + (h)) * HTB)
#define PG8_STAGE(bufoff, gbase, voff) do { _Pragma("unroll") for (int _i = 0; _i < 2; ++_i) \
        __builtin_amdgcn_global_load_lds((const unsigned*)((const char*)(gbase) + (voff)[_i]), (LAS unsigned*)(lds + (bufoff) + ldsw + _i * 8192), 16, 0, 0); } while (0)
#define PG8_LDA(dst, b, h) do { _Pragma("unroll") for (int m = 0; m < 4; ++m) _Pragma("unroll") for (int k = 0; k < 2; ++k) dst[m][k] = *(const LAS bf16x8*)(lds + PG8_SA(b, h) + aoff + m * 2048 + k * 1024); } while (0)
#define PG8_LDB(dst, b, h) do { _Pragma("unroll") for (int n = 0; n < 2; ++n) _Pragma("unroll") for (int k = 0; k < 2; ++k) dst[n][k] = *(const LAS bf16x8*)(lds + PG8_SB(b, h) + boff + n * 2048 + k * 1024); } while (0)
#define PG8_MMA(ai, bj, At, Bt) do { __builtin_amdgcn_s_setprio(1); _Pragma("unroll") for (int m = 0; m < 4; ++m) _Pragma("unroll") for (int n = 0; n < 2; ++n) _Pragma("unroll") for (int k = 0; k < 2; ++k) \
        acc[ai][bj][m][n] = __builtin_amdgcn_mfma_f32_16x16x32_bf16(Bt[n][k], At[m][k], acc[ai][bj][m][n], 0, 0, 0); __builtin_amdgcn_s_setprio(0); } while (0)
#define PG8_WAIT_V(n) asm volatile("s_waitcnt vmcnt(" #n ")" ::: "memory")
#define PG8_WAIT_L(n) asm volatile("s_waitcnt lgkmcnt(" #n ")" ::: "memory")
#define PG8_BAR __builtin_amdgcn_s_barrier()
#define PG8_SCHED __builtin_amdgcn_sched_barrier(0)
    Unit cur, nxt; int ui = 0;
    if (!J.next(0, cur)) return;
    f32x4 acc[2][2][4][2];
#pragma unroll
    for (int a = 0; a < 2; ++a)
#pragma unroll
        for (int b = 0; b < 2; ++b)
#pragma unroll
            for (int m = 0; m < 4; ++m)
#pragma unroll
                for (int n = 0; n < 2; ++n) acc[a][b][m][n] = (f32x4){0.f, 0.f, 0.f, 0.f};
    bf16x8 At[4][2], B0[2][2], B1[2][2];
    const char* cA; const char* cB;
    J.ptrs(cur, cA, cB);
    PG8_STAGE(PG8_SB(0, 0), cB, voffB); PG8_STAGE(PG8_SB(0, 1), cB + hstepB, voffB); PG8_STAGE(PG8_SA(0, 0), cA, voffA); PG8_STAGE(PG8_SA(0, 1), cA + hstepA, voffA);
    if (wr == 1) PG8_BAR;
    PG8_WAIT_V(2); PG8_BAR;
    PG8_STAGE(PG8_SB(1, 0), cB + kstep, voffB); PG8_STAGE(PG8_SA(1, 0), cA + kstep, voffA); PG8_STAGE(PG8_SB(1, 1), cB + hstepB + kstep, voffB);
    PG8_WAIT_V(6); PG8_BAR;
    for (;;) {
        const bool has_next = J.next(ui + 1, nxt);
        const char* nA = cA; const char* nB = cB;
        if (has_next) J.ptrs(nxt, nA, nB);
        for (int t = 0; t < nt; t += 2) {
            if constexpr (Epi::HOOK) { if (E.want(t)) E.hook(acc, cur, t, wr, wc, fr, fq); }
            const bool last = (t == nt - 2);
            const char* a1 = cA + (size_t)(t + 1) * kstep;
            const char* a2 = last ? nA : cA + (size_t)(t + 2) * kstep; const char* b2 = last ? nB : cB + (size_t)(t + 2) * kstep;
            const char* a3 = a2 + kstep; const char* b3 = b2 + kstep;
            PG8_LDB(B0, 0, 0); PG8_LDB(B1, 0, 1); PG8_SCHED; PG8_LDA(At, 0, 0); PG8_STAGE(PG8_SA(1, 1), a1 + hstepA, voffA);
            PG8_WAIT_V(8); PG8_WAIT_L(0); PG8_BAR; PG8_MMA(0, 0, At, B0); PG8_MMA(0, 1, At, B1); PG8_BAR; PG8_SCHED;
            PG8_LDA(At, 0, 1); PG8_STAGE(PG8_SB(0, 0), b2, voffB); PG8_STAGE(PG8_SB(0, 1), b2 + hstepB, voffB); PG8_STAGE(PG8_SA(0, 0), a2, voffA);
            PG8_WAIT_V(8); PG8_WAIT_L(0); PG8_BAR; PG8_MMA(1, 0, At, B0); PG8_MMA(1, 1, At, B1); PG8_BAR; PG8_SCHED;
            PG8_LDB(B0, 1, 0); PG8_LDB(B1, 1, 1); PG8_SCHED; PG8_LDA(At, 1, 0); PG8_STAGE(PG8_SA(0, 1), a2 + hstepA, voffA);
            PG8_WAIT_V(8); PG8_WAIT_L(0); PG8_BAR; PG8_MMA(0, 0, At, B0); PG8_MMA(0, 1, At, B1); PG8_BAR; PG8_SCHED;
            PG8_LDA(At, 1, 1); PG8_STAGE(PG8_SB(1, 0), b3, voffB); PG8_STAGE(PG8_SB(1, 1), b3 + hstepB, voffB); PG8_STAGE(PG8_SA(1, 0), a3, voffA);
            PG8_WAIT_V(8); PG8_WAIT_L(0); PG8_BAR; PG8_MMA(1, 0, At, B0); PG8_MMA(1, 1, At, B1); PG8_BAR; PG8_SCHED;
        }
        if (wr == 0) PG8_BAR;
        { int fr_ = fr, fq_ = fq; asm volatile("" : "+v"(fr_), "+v"(fq_));
          E(acc, cur, wr, wc, fr_, fq_); }
        if (!has_next) break;
#pragma unroll
        for (int a = 0; a < 2; ++a)
#pragma unroll
            for (int b = 0; b < 2; ++b)
#pragma unroll
                for (int m = 0; m < 4; ++m)
#pragma unroll
                    for (int n = 0; n < 2; ++n) acc[a][b][m][n] = (f32x4){0.f, 0.f, 0.f, 0.f};
        cur = nxt; cA = nA; cB = nB; ++ui;
        if (wr == 1) PG8_BAR;
    }
    PG8_WAIT_V(0);
    PG8_BAR;
#undef PG8_SA
#undef PG8_SB
#undef PG8_STAGE
#undef PG8_LDA
#undef PG8_LDB
#undef PG8_MMA
#undef PG8_WAIT_V
#undef PG8_WAIT_L
#undef PG8_BAR
#undef PG8_SCHED
}
}
using pg8::Unit;

struct Job {
    const bf16_t* A; const bf16_t* B; int lda, ldb, K;
    int nM, nN, nX, G, c;
    long sAm, sAn, sAx, sBm, sBn, sBx;
    int order;
    __device__ __forceinline__ bool next(int i, Unit& u) const {
        const int L = i * G + c; const int per = nM * nN;
        if (L >= per * nX) return false;
        const int x = L / per; int r = L - x * per;
        u.x = x;
        if (order == 1) {
            { const int q = per / 8, rr = per % 8, xcd = r % 8, off = r / 8; r = (xcd < rr ? xcd * (q + 1) : rr * (q + 1) + (xcd - rr) * q) + off; }
            const int nig = 8 * nN, gid = r / nig, fm = gid * 8, gsz = (nM - fm) < 8 ? (nM - fm) : 8;
            u.pm = fm + ((r % nig) % gsz); u.pn = (r % nig) / gsz;
        } else { u.pm = r % nM; u.pn = r / nM; }
        return true;
    }
    __device__ __forceinline__ void ptrs(const Unit& u, const char*& a, const char*& b) const {
        a = (const char*)(A + (long)u.pm * sAm + (long)u.pn * sAn + (long)u.x * sAx);
        b = (const char*)(B + (long)u.pm * sBm + (long)u.pn * sBn + (long)u.x * sBx);
    }
};

#define EPI_ARGS const f32x4 (&acc)[2][2][4][2], const Unit& u, int wr, int wc, int fr, int fq

struct EpiIn {
    static constexpr bool HOOK = false;
    bf16_t* ACT; float* out_dk; float* out_nk; const float* rope; int layer; bf16_t* GF;
    __device__ __forceinline__ void operator()(EPI_ARGS) const {
        const int seg = u.pn >> 1; const bool lat = u.pm >= 32;
        int pm_ = u.pm, pn_ = u.pn; asm volatile("" : "+s"(pm_), "+s"(pn_));
        bf16_t* gft = (seg >= 8) ? GF + (size_t)(pm_ * GF_TILES + (pn_ - 16)) * GF_TILE : nullptr;
        const int bstride = (seg >= 8) ? 512 : 128;
        int mode = 0;
        if (seg == 8 || seg == 9) mode = 1;
        else if (seg >= 10) mode = 2;
        else if (seg == 2 || seg == 5) mode = 3;
        const bool dorope = lat && (seg == 2 || seg == 3);
        float* fo = nullptr;
        if (!lat && seg == 3) fo = out_dk; else if (!lat && seg == 6) fo = out_nk;
        const int cq = wc * 32 + 8 * fq;
#pragma unroll
        for (int ai = 0; ai < 2; ++ai)
#pragma unroll
            for (int m = 0; m < 4; ++m) {
                const int rt = ai * 128 + wr * 64 + m * 16 + fr;
                const size_t row = (size_t)u.pm * 256 + rt;
                bf16_t* arow = gft ? gft + gf_off(wr, wc, ai, m, 0, fr + 16 * fq) : ACT + row * LDACT + (size_t)u.pn * 256 + cq;
                f32x4 cs0 = {1.f, 1.f, 1.f, 1.f}, cs1 = cs0, sn0 = {0.f, 0.f, 0.f, 0.f}, sn1 = sn0;
                if (dorope) { const int t = (int)(row - TCTX) & 4095; const int pos = (wc & 1) ? (t & 63) : (t >> 6);
                    const float* rp = rope + pos * 32 + 8 * (fq & 1); const float sg = (fq < 2) ? -1.0f : 1.0f;
                    cs0 = *(const f32x4*)rp; cs1 = *(const f32x4*)(rp + 4); sn0 = *(const f32x4*)(rp + 16) * sg; sn1 = *(const f32x4*)(rp + 20) * sg; }
#pragma unroll
                for (int bj = 0; bj < 2; ++bj) {
                    f32x4 v0 = acc[ai][bj][m][0], v1 = acc[ai][bj][m][1];
                    if (fo) {
                        float* fp = fo + ((size_t)(u.pm * 4 + layer) * 256 + rt) * 512 + (u.pn & 1) * 256 + bj * 128 + cq;
                        *(f32x4*)fp = v0; *(f32x4*)(fp + 4) = v1;
                    }
                    if (dorope) {
                        f32x4 p0, p1;
#pragma unroll
                        for (int j = 0; j < 4; ++j) { p0[j] = __shfl_xor(v0[j], 32); p1[j] = __shfl_xor(v1[j], 32); }
                        v0 = v0 * cs0 + p0 * sn0; v1 = v1 * cs1 + p1 * sn1;
                    }
                    if (mode == 1) {
#pragma unroll
                        for (int j = 0; j < 4; ++j) { v0[j] = siluf_(v0[j]); v1[j] = siluf_(v1[j]); }
                    } else if (mode == 2) {
#pragma unroll
                        for (int j = 0; j < 4; ++j) { v0[j] = einvsig_(v0[j]); v1[j] = einvsig_(v1[j]); }
                    } else if (mode == 3) { v0 = v0 * QSCALE; v1 = v1 * QSCALE; }
                    u32x4 w; w.x = pk2(v0[0], v0[1]); w.y = pk2(v0[2], v0[3]); w.z = pk2(v1[0], v1[1]); w.w = pk2(v1[2], v1[3]);
                    *(u32x4*)(arow + bj * bstride) = w;
                }
            }
    }
};
struct EpiInT {
    static constexpr bool HOOK = false;
    bf16_t* XT; float* out_dv; float* out_nv; int layer;
    __device__ __forceinline__ void operator()(EPI_ARGS) const {
        float* fo = nullptr;
        if (u.pn < 32 && u.pm >= 2) fo = (u.pm < 4) ? out_dv : out_nv;
        const int cq = wc * 32 + 8 * fq;
#pragma unroll
        for (int ai = 0; ai < 2; ++ai)
#pragma unroll
            for (int m = 0; m < 4; ++m) {
                const int rt = ai * 128 + wr * 64 + m * 16 + fr;
                const int feat = u.pm * 256 + rt;
                bf16_t* xrow = XT + (size_t)feat * TOK + (size_t)u.pn * 256 + cq;
#pragma unroll
                for (int bj = 0; bj < 2; ++bj) {
                    const f32x4 v0 = acc[ai][bj][m][0], v1 = acc[ai][bj][m][1];
                    u32x4 w; w.x = pk2(v0[0], v0[1]); w.y = pk2(v0[2], v0[3]); w.z = pk2(v1[0], v1[1]); w.w = pk2(v1[2], v1[3]);
                    *(u32x4*)(xrow + bj * 128) = w;
                    if (fo) { const int s0 = bj * 128 + cq; const int f512 = feat & 511;
                        float* fp = fo + ((size_t)(u.pn * 4 + layer) * 256 + s0) * 512 + f512;
                        fp[0] = v0[0]; fp[512] = v0[1]; fp[1024] = v0[2]; fp[1536] = v0[3];
                        fp[2048] = v1[0]; fp[2560] = v1[1]; fp[3072] = v1[2]; fp[3584] = v1[3]; }
                }
            }
    }
};
struct EpiCdft {
    static constexpr bool HOOK = false;
    bf16_t* YTC; bf16_t* YTL;
    __device__ __forceinline__ void operator()(EPI_ARGS) const {
        const int g = u.pm >> 1, part = u.pm & 1;
        bf16_t* base; size_t ld;
        if (u.pn < 32) { base = YTC + ((size_t)u.pn * 1024 + g * 256) * 512 + part * 256; ld = 512; }
        else { const int q = u.pn - 32; base = YTL + ((size_t)(q >> 4) * 1024 + g * 256) * 8192 + part * 4096 + (q & 15) * 256; ld = 8192; }
#pragma unroll
        for (int ai = 0; ai < 2; ++ai)
#pragma unroll
            for (int m = 0; m < 4; ++m) {
                const int rt = ai * 128 + wr * 64 + m * 16 + fr;
                bf16_t* yrow = base + (size_t)rt * ld + wc * 32 + 8 * fq;
#pragma unroll
                for (int bj = 0; bj < 2; ++bj) { const f32x4 v0 = acc[ai][bj][m][0], v1 = acc[ai][bj][m][1];
                    u32x4 w; w.x = pk2(v0[0], v0[1]); w.y = pk2(v0[2], v0[3]); w.z = pk2(v1[0], v1[1]); w.w = pk2(v1[2], v1[3]);
                    *(u32x4*)(yrow + bj * 128) = w; }
            }
    }
};
struct EpiPdftCtx {
    static constexpr bool HOOK = false;
    const bf16_t* ACT; bf16_t* YCAT; int tokbase, xstride;
    __device__ __forceinline__ void operator()(EPI_ARGS) const {
        const unsigned r0 = (unsigned)tokbase + (unsigned)u.x * xstride + (unsigned)u.pm * 256 + wr * 64 + fr;
        const unsigned c0 = u.pn * 256 + wc * 32 + 8 * fq;
        const bf16_t* gft = ACT + (size_t)(((tokbase + u.x * xstride) >> 8) + u.pm) * GF_TILES * GF_TILE + (size_t)u.pn * GF_TILE;
#pragma unroll
        for (int ai = 0; ai < 2; ++ai) {
            u32x4 gt[4][2];
#pragma unroll
            for (int m = 0; m < 4; ++m)
#pragma unroll
                for (int bj = 0; bj < 2; ++bj) gt[m][bj] = *(const u32x4*)(gft + gf_off(wr, wc, ai, m, bj, fr + 16 * fq));
#pragma unroll
            for (int m = 0; m < 4; ++m)
#pragma unroll
                for (int bj = 0; bj < 2; ++bj) { const f32x4 v0 = acc[ai][bj][m][0], v1 = acc[ai][bj][m][1]; const u32x4 g = gt[m][bj];
                    u32x4 w; w.x = pk2(v0[0] * bflo(g.x), v0[1] * bfhi(g.x)); w.y = pk2(v0[2] * bflo(g.y), v0[3] * bfhi(g.y));
                    w.z = pk2(v1[0] * bflo(g.z), v1[1] * bfhi(g.z)); w.w = pk2(v1[2] * bflo(g.w), v1[3] * bfhi(g.w));
                    *(u32x4*)(YCAT + (size_t)(r0 + ai * 128 + m * 16) * LDY + Y_F + c0 + bj * 128) = w; }
        }
    }
};
struct EpiPdftLat {
    static constexpr bool HOOK = false;
    float* PF;
    __device__ __forceinline__ void operator()(EPI_ARGS) const {
        const int part = u.x >> 1, b = u.x & 1;
#pragma unroll
        for (int ai = 0; ai < 2; ++ai)
#pragma unroll
            for (int m = 0; m < 4; ++m) {
                const int rt = ai * 128 + wr * 64 + m * 16 + fr;
                float* prow = PF + ((size_t)part * 8192 + (size_t)b * 4096 + (size_t)u.pm * 256 + rt) * 1024 + u.pn * 256 + wc * 32 + 8 * fq;
#pragma unroll
                for (int bj = 0; bj < 2; ++bj) { *(f32x4*)(prow + bj * 128) = acc[ai][bj][m][0]; *(f32x4*)(prow + bj * 128 + 4) = acc[ai][bj][m][1]; }
            }
    }
};
struct EpiMix {
    static constexpr bool HOOK = true;
    const bf16_t* ACT; bf16_t* MIXB;
    __device__ __forceinline__ bool want(int t) const { return t == 8 || t == 16 || t == 24; }
    __device__ __forceinline__ void hook(f32x4 (&acc)[2][2][4][2], const Unit& u, int t, int wr, int wc, int fr, int fq) const {
        const int b = (t >> 3) - 1;
        unsigned r0 = (unsigned)u.pm * 256 + wr * 64 + fr, cq = wc * 32 + 8 * fq; int lane_ = fr + 16 * fq;
        asm volatile("" : "+v"(r0), "+v"(cq), "+v"(lane_));
        const bf16_t* gp = ACT + (size_t)(u.pm * GF_TILES + 4 + b * 4 + u.pn) * GF_TILE;
        (void)r0; (void)cq;
        u32x4 ga[2][2][2], gb[2][2][2];
#define MIX_LD(buf, ai, mp) do { _Pragma("unroll") for (int mm = 0; mm < 2; ++mm) _Pragma("unroll") for (int bj = 0; bj < 2; ++bj) { \
            const bf16_t* p = gp + gf_off(wr, wc, ai, (mp) * 2 + mm, bj, lane_); ga[buf][mm][bj] = *(const u32x4*)p; gb[buf][mm][bj] = *(const u32x4*)(p + 4 * GF_TILE); } } while (0)
#define MIX_AP(buf, ai, mp) do { _Pragma("unroll") for (int mm = 0; mm < 2; ++mm) _Pragma("unroll") for (int bj = 0; bj < 2; ++bj) { \
            const u32x4 a = ga[buf][mm][bj], d = gb[buf][mm][bj]; f32x4& v0 = acc[ai][bj][(mp) * 2 + mm][0]; f32x4& v1 = acc[ai][bj][(mp) * 2 + mm][1]; \
            v0[0] *= bflo(d.x) * __builtin_amdgcn_rcpf(bflo(a.x)); v0[1] *= bfhi(d.x) * __builtin_amdgcn_rcpf(bfhi(a.x)); \
            v0[2] *= bflo(d.y) * __builtin_amdgcn_rcpf(bflo(a.y)); v0[3] *= bfhi(d.y) * __builtin_amdgcn_rcpf(bfhi(a.y)); \
            v1[0] *= bflo(d.z) * __builtin_amdgcn_rcpf(bflo(a.z)); v1[1] *= bfhi(d.z) * __builtin_amdgcn_rcpf(bfhi(a.z)); \
            v1[2] *= bflo(d.w) * __builtin_amdgcn_rcpf(bflo(a.w)); v1[3] *= bfhi(d.w) * __builtin_amdgcn_rcpf(bfhi(a.w)); } } while (0)
        MIX_LD(0, 0, 0); MIX_LD(1, 0, 1);
        MIX_AP(0, 0, 0); asm volatile("" ::: "memory"); MIX_LD(0, 1, 0);
        MIX_AP(1, 0, 1); asm volatile("" ::: "memory"); MIX_LD(1, 1, 1);
        MIX_AP(0, 1, 0); MIX_AP(1, 1, 1);
        asm volatile("" ::: "memory");
#undef MIX_LD
#undef MIX_AP
    }
    __device__ __forceinline__ void operator()(EPI_ARGS) const {
        const unsigned r0 = (unsigned)u.pm * 256 + wr * 64 + fr;
        const unsigned c0 = u.pn * 256 + wc * 32 + 8 * fq;
        const bf16_t* gp = ACT + (size_t)(u.pm * GF_TILES + 4 + 12 + u.pn) * GF_TILE;
#pragma unroll
        for (int ai = 0; ai < 2; ++ai) {
            u32x4 ga[4][2];
#pragma unroll
            for (int m = 0; m < 4; ++m)
#pragma unroll
                for (int bj = 0; bj < 2; ++bj) ga[m][bj] = *(const u32x4*)(gp + gf_off(wr, wc, ai, m, bj, fr + 16 * fq));
#pragma unroll
            for (int m = 0; m < 4; ++m)
#pragma unroll
                for (int bj = 0; bj < 2; ++bj) { const f32x4 v0 = acc[ai][bj][m][0], v1 = acc[ai][bj][m][1]; const u32x4 a = ga[m][bj];
#define RC_(x) __builtin_amdgcn_rcpf(x)
                    u32x4 w; w.x = pk2(v0[0] * RC_(bflo(a.x)), v0[1] * RC_(bfhi(a.x))); w.y = pk2(v0[2] * RC_(bflo(a.y)), v0[3] * RC_(bfhi(a.y)));
                    w.z = pk2(v1[0] * RC_(bflo(a.z)), v1[1] * RC_(bfhi(a.z))); w.w = pk2(v1[2] * RC_(bflo(a.w)), v1[3] * RC_(bfhi(a.w)));
#undef RC_
                    *(u32x4*)(MIXB + (size_t)(r0 + ai * 128 + m * 16) * 1024 + c0 + bj * 128) = w; }
        }
    }
};
struct EpiOut {
    static constexpr bool HOOK = false;
    bf16_t* O;
    __device__ __forceinline__ void operator()(EPI_ARGS) const {
#pragma unroll
        for (int ai = 0; ai < 2; ++ai)
#pragma unroll
            for (int m = 0; m < 4; ++m) {
                const int rt = ai * 128 + wr * 64 + m * 16 + fr;
                bf16_t* orow = O + ((size_t)u.pm * 256 + rt) * 1024 + u.pn * 256 + wc * 32 + 8 * fq;
#pragma unroll
                for (int bj = 0; bj < 2; ++bj) { const f32x4 v0 = acc[ai][bj][m][0], v1 = acc[ai][bj][m][1];
                    u32x4 w; w.x = pk2(v0[0], v0[1]); w.y = pk2(v0[2], v0[3]); w.z = pk2(v1[0], v1[1]); w.w = pk2(v1[2], v1[3]);
                    *(u32x4*)(orow + bj * 128) = w; }
            }
    }
};

struct KVSrc { const bf16_t* k0; int ldk0; const bf16_t* v0; int ldv0; int n0; const bf16_t* k1; int ldk1; const bf16_t* v1; int ldv1; };

#define MFMA32(a, b, c) __builtin_amdgcn_mfma_f32_32x32x16_bf16((a), (b), (c), 0, 0, 0)

template <int DV, int KW, int MODE, int NVS>
__device__ __forceinline__ void attn_core(LAS unsigned char* lds, const bf16_t* qrow, const KVSrc& S, int nT, int kcol, int vrow,
                                          const LAS float* rpbh, int dr0, int qc, f32x16 (&o)[DV / 32], float& lsum) {
    constexpr int KS = KW + 8, VS = 72, NCH = KW / 64;
    constexpr int KBYTES = 64 * KS * 2, VBYTES = KW * VS * 2;
    constexpr bool SKEW = (NVS == 3);
    static_assert(2 * KBYTES + NVS * VBYTES <= 141312, "attention LDS");
    const int tid = ltid(), lane = tid & 63, r32 = lane & 31, hi = lane >> 5;
    const bool late = SKEW && (__builtin_amdgcn_readfirstlane(tid >> 6) >= 4);
    u32x4 kr[NCH], vr[NCH];
#define A_GLOAD(t) do { const bf16_t* kp_; const bf16_t* vp_; int lk_, lv_; \
        if ((t) < S.n0) { kp_ = S.k0 + (size_t)(t) * 64 * S.ldk0; lk_ = S.ldk0; vp_ = S.v0 + (size_t)(t) * 64; lv_ = S.ldv0; } \
        else { kp_ = S.k1 + (size_t)((t) - S.n0) * 64 * S.ldk1; lk_ = S.ldk1; vp_ = S.v1 + (size_t)((t) - S.n0) * 64; lv_ = S.ldv1; } \
        _Pragma("unroll") for (int c_ = 0; c_ < NCH; ++c_) { const int id_ = tid + NTHR * c_; \
            kr[c_] = *(const u32x4*)(kp_ + (size_t)(id_ / (KW / 8)) * lk_ + (id_ % (KW / 8)) * 8); \
            vr[c_] = *(const u32x4*)(vp_ + (size_t)(id_ >> 3) * lv_ + (id_ & 7) * 8); } } while (0)
#define A_LSTORE(kslot, vslot) do { LAS bf16_t* kt_ = (LAS bf16_t*)(lds + (kslot) * KBYTES); LAS bf16_t* vt_ = (LAS bf16_t*)(lds + 2 * KBYTES + (vslot) * VBYTES); \
        _Pragma("unroll") for (int c_ = 0; c_ < NCH; ++c_) { const int id_ = tid + NTHR * c_; \
            *(LAS u32x4*)(kt_ + (id_ / (KW / 8)) * KS + (id_ % (KW / 8)) * 8) = kr[c_]; \
            { LAS bf16_t* vd_ = vt_ + (id_ >> 3) * VS + 16 * ((id_ & 7) >> 1) + 4 * (id_ & 1); \
              *(LAS u32x2*)vd_ = (u32x2){vr[c_].x, vr[c_].y}; *(LAS u32x2*)(vd_ + 8) = (u32x2){vr[c_].z, vr[c_].w}; } } } while (0)
#define A_PV(vslot) do { const LAS bf16_t* Vt_ = (const LAS bf16_t*)(lds + 2 * KBYTES + (vslot) * VBYTES); \
        _Pragma("unroll") for (int b = 0; b < DV / 32; ++b) { const LAS bf16_t* vp = Vt_ + (vrow + 32 * b + r32) * VS + 8 * hi; \
            _Pragma("unroll") for (int kh = 0; kh < 2; ++kh) _Pragma("unroll") for (int s = 0; s < 2; ++s) { \
                const bf16x8 va = *(const LAS bf16x8*)(vp + 32 * kh + 16 * s); o[b] = MFMA32(va, pf[kh][s], o[b]); } } } while (0)
    bf16x8 qf[4];
#pragma unroll
    for (int d0 = 0; d0 < 4; ++d0) qf[d0] = *(const bf16x8*)(qrow + d0 * 16 + hi * 8);
    float mrun = 0.f; lsum = 0.f;
    f32x16 negm;
#pragma unroll
    for (int j = 0; j < 16; ++j) negm[j] = 0.f;
#pragma unroll
    for (int b = 0; b < DV / 32; ++b)
#pragma unroll
        for (int j = 0; j < 16; ++j) o[b][j] = 0.f;
    bf16x8 pf[2][2];
#pragma unroll
    for (int a_ = 0; a_ < 2; ++a_)
#pragma unroll
        for (int b_ = 0; b_ < 2; ++b_) pf[a_][b_] = (bf16x8){0, 0, 0, 0, 0, 0, 0, 0};
    A_GLOAD(0); A_LSTORE(0, 0); if (nT > 1) A_GLOAD(1); __syncthreads();
    int vprev = 0, vcur = 0, vnext = 1;
    for (int t = 0; t < nT; ++t) {
        const int buf = t & 1;
        if (t + 1 < nT) A_LSTORE(buf ^ 1, vnext);
        if (t + 2 < nT) A_GLOAD(t + 2);
        if (late && t > 0) A_PV(vprev);
        const LAS bf16_t* Kt = (const LAS bf16_t*)(lds + buf * KBYTES);
        f32x16 p0, p1;
#pragma unroll
        for (int d0 = 0; d0 < 4; ++d0) {
            const bf16x8 a0 = *(const LAS bf16x8*)(Kt + r32 * KS + kcol + d0 * 16 + hi * 8);
            const bf16x8 a1 = *(const LAS bf16x8*)(Kt + (32 + r32) * KS + kcol + d0 * 16 + hi * 8);
            if (d0 == 0) { p0 = MFMA32(a0, qf[0], negm); p1 = MFMA32(a1, qf[0], negm); }
            else { p0 = MFMA32(a0, qf[d0], p0); p1 = MFMA32(a1, qf[d0], p1); }
        }
        if (MODE == 2 && t < 8) {
            const int c0 = min(max(qc - 8, 0), 48);
            const LAS float* rb = rpbh + (dr0 + t + 7) * 31 + 15 - qc;
#pragma unroll
            for (int j = 0; j < 16; ++j) { const int kc = crow(j, hi);
                p0[j] = (kc >= c0 && kc < c0 + 16) ? p0[j] + rb[kc] : -INFINITY;
                const int kc1 = kc + 32;
                p1[j] = (kc1 >= c0 && kc1 < c0 + 16) ? p1[j] + rb[kc1] : -INFINITY; }
        }
        float ma = __builtin_fmaxf(__builtin_fmaxf(p0[0], p0[1]), p1[0]), mb = __builtin_fmaxf(__builtin_fmaxf(p0[2], p0[3]), p1[1]);
        ma = __builtin_fmaxf(__builtin_fmaxf(ma, p1[2]), p1[3]);
#pragma unroll
        for (int j = 4; j < 16; j += 4) { ma = __builtin_fmaxf(__builtin_fmaxf(ma, p0[j]), p0[j + 1]); mb = __builtin_fmaxf(__builtin_fmaxf(mb, p0[j + 2]), p0[j + 3]);
            ma = __builtin_fmaxf(__builtin_fmaxf(ma, p1[j]), p1[j + 1]); mb = __builtin_fmaxf(__builtin_fmaxf(mb, p1[j + 2]), p1[j + 3]); }
        float mx = __builtin_fmaxf(ma, mb);
        { auto rr_ = __builtin_amdgcn_permlane32_swap(__float_as_uint(mx), __float_as_uint(mx), false, false); mx = fmaxf(__uint_as_float(rr_[0]), __uint_as_float(rr_[1])); }
        if (t == 0 || __any(mx > 6.0f)) {
            const float dl = (t == 0) ? mx : __builtin_fmaxf(mx, 0.f);
            mrun += dl;
#pragma unroll
            for (int j = 0; j < 16; ++j) { p0[j] -= dl; p1[j] -= dl; }
            if (t > 0) { const float f = fexp2(-dl); lsum *= f;
#pragma unroll
                for (int b = 0; b < DV / 32; ++b)
#pragma unroll
                    for (int j = 0; j < 16; ++j) o[b][j] *= f; }
#pragma unroll
            for (int j = 0; j < 16; ++j) negm[j] = -mrun;
        }
        f32x2_t sa = {0.f, 0.f}, sb = {0.f, 0.f};
#pragma unroll
        for (int j = 0; j < 16; j += 2) { p0[j] = fexp2(p0[j]); p0[j + 1] = fexp2(p0[j + 1]); p1[j] = fexp2(p1[j]); p1[j + 1] = fexp2(p1[j + 1]);
            sa += (f32x2_t){p0[j], p0[j + 1]}; sb += (f32x2_t){p1[j], p1[j + 1]}; }
        sa += sb; lsum += sa[0] + sa[1];
#pragma unroll
        for (int s = 0; s < 2; ++s) {
            u32x4 w0, w1;
            w0.x = pk2(p0[8 * s + 0], p0[8 * s + 1]); w0.y = pk2(p0[8 * s + 2], p0[8 * s + 3]); w0.z = pk2(p0[8 * s + 4], p0[8 * s + 5]); w0.w = pk2(p0[8 * s + 6], p0[8 * s + 7]);
            w1.x = pk2(p1[8 * s + 0], p1[8 * s + 1]); w1.y = pk2(p1[8 * s + 2], p1[8 * s + 3]); w1.z = pk2(p1[8 * s + 4], p1[8 * s + 5]); w1.w = pk2(p1[8 * s + 6], p1[8 * s + 7]);
            pf[0][s] = __builtin_bit_cast(bf16x8, w0); pf[1][s] = __builtin_bit_cast(bf16x8, w1);
        }
        if (!late) A_PV(vcur);
        __syncthreads();
        vprev = vcur; vcur = vnext; vnext = (vnext + 1 == NVS) ? 0 : vnext + 1;
    }
    if (SKEW) { if (late) A_PV(vprev); __syncthreads(); }
#undef A_PV
#undef A_GLOAD
#undef A_LSTORE
}

__device__ __forceinline__ void attn_store64(const f32x16 (&o)[2], float lsum, const bf16_t* gate, bf16_t* yout, int hi) {
    const float l = lsum + __shfl_xor(lsum, 32); const float inv = __builtin_amdgcn_rcpf(l);
    u32x2 gt[2][4];
#pragma unroll
    for (int b = 0; b < 2; ++b)
#pragma unroll
        for (int g = 0; g < 4; ++g) gt[b][g] = *(const u32x2*)(gate + 32 * b + 8 * g + 4 * hi);
#pragma unroll
    for (int b = 0; b < 2; ++b)
#pragma unroll
        for (int g = 0; g < 4; ++g) { const int dv = 32 * b + 8 * g + 4 * hi; const u32x2 q = gt[b][g];
            u32x2 w; w.x = pk2(o[b][4 * g] * inv * siluf_(bflo(q.x)), o[b][4 * g + 1] * inv * siluf_(bfhi(q.x)));
            w.y = pk2(o[b][4 * g + 2] * inv * siluf_(bflo(q.y)), o[b][4 * g + 3] * inv * siluf_(bfhi(q.y)));
            *(u32x2*)(yout + dv) = w; }
}

__device__ __forceinline__ void diff_unit(LAS unsigned char* lds, const bf16_t* ACT, bf16_t* YCAT, const KVSrc& S, int nT, size_t tok0, int h,
                                          float lam, float lam_init, const float* subln) {
    const int tid = ltid(), wid = __builtin_amdgcn_readfirstlane(tid >> 6), lane = tid & 63, r32 = lane & 31, hi = lane >> 5;
    const int map = wid >> 2, qs = wid & 3;
    const size_t tok = tok0 + qs * 32 + r32;
    f32x16 o[4]; float lsum;
    attn_core<128, 128, 0, 3>(lds, ACT + tok * LDACT + A_DQ + h * 128 + map * 64, S, nT, map * 64, 0, nullptr, 0, 0, o, lsum);
    const float l = lsum + __shfl_xor(lsum, 32); const float inv = __builtin_amdgcn_rcpf(l);
    LAS float* X = (LAS float*)lds;
    if (map == 1) {
#pragma unroll
        for (int b = 0; b < 4; ++b)
#pragma unroll
            for (int j = 0; j < 16; ++j) X[((qs * 64) + b * 16 + j) * 64 + lane] = o[b][j] * inv;
    }
    __syncthreads();
    if (map == 0) {
        float ssq = 0.f;
#pragma unroll
        for (int b = 0; b < 4; ++b)
#pragma unroll
            for (int j = 0; j < 16; ++j) { const float d = o[b][j] * inv - lam * X[((qs * 64) + b * 16 + j) * 64 + lane]; o[b][j] = d; ssq += d * d; }
        ssq += __shfl_xor(ssq, 32);
        const float rs = rsqrtf(ssq * (1.0f / 128.0f) + EPSN) * (1.0f - lam_init);
        const bf16_t* gate = ACT + tok * LDACT + A_DG + h * 128;
        bf16_t* yout = YCAT + tok * LDY + Y_D + h * 128;
        u32x2 gt[4][4];
#pragma unroll
        for (int b = 0; b < 4; ++b)
#pragma unroll
            for (int g = 0; g < 4; ++g) gt[b][g] = *(const u32x2*)(gate + 32 * b + 8 * g + 4 * hi);
#pragma unroll
        for (int b = 0; b < 4; ++b)
#pragma unroll
            for (int g = 0; g < 4; ++g) { const int dv = 32 * b + 8 * g + 4 * hi;
                const u32x2 q = gt[b][g]; const f32x4 sg = *(const f32x4*)(subln + dv);
                u32x2 w; w.x = pk2(o[b][4 * g] * rs * sg[0] * siluf_(bflo(q.x)), o[b][4 * g + 1] * rs * sg[1] * siluf_(bfhi(q.x)));
                w.y = pk2(o[b][4 * g + 2] * rs * sg[2] * siluf_(bflo(q.y)), o[b][4 * g + 3] * rs * sg[3] * siluf_(bfhi(q.y)));
                *(u32x2*)(yout + dv) = w; }
    }
    __syncthreads();
}

__device__ __forceinline__ void spatial_unit(LAS unsigned char* lds, int chunk, const bf16_t* ACT, const bf16_t* SGVT, const bf16_t* SGW,
                                             const float* sgb, const float* sgng, bf16_t* YCAT) {
    const int tid = ltid(), wid = __builtin_amdgcn_readfirstlane(tid >> 6), lane = tid & 63, r32 = lane & 31, hi = lane >> 5;
    LAS float* part = (LAS float*)lds;
    LAS float* rr = part + 512;
    const size_t t0 = (size_t)chunk * 128;
    { const int tk = tid & 127, cq = tid >> 7; float s = 0.f;
#pragma unroll 16
      for (int c = cq * 128; c < cq * 128 + 128; ++c) { const float v = bf2f(SGVT[(size_t)c * TOK + t0 + tk]); s += v * v; }
      part[cq * 128 + tk] = s; }
    __syncthreads();
    if (tid < 128) rr[tid] = rsqrtf((part[tid] + part[128 + tid] + part[256 + tid] + part[384 + tid]) * (1.0f / 512.0f) + EPSN);
    __syncthreads();
    const int g = wid;
    const bf16_t* Wg = SGW + (size_t)g * 128 * 128;
#pragma unroll 1
    for (int cb = 0; cb < 2; ++cb) {
        bf16x8 vb[8];
        const unsigned c = g * 64 + cb * 32 + r32;
#pragma unroll
        for (int s = 0; s < 8; ++s) {
            const f32x4 r0 = *(const LAS f32x4*)(rr + 16 * s + 8 * hi), r1 = *(const LAS f32x4*)(rr + 16 * s + 8 * hi + 4);
            const u32x4 raw = *(const u32x4*)(SGVT + (size_t)c * TOK + t0 + 16 * s + 8 * hi);
            u32x4 w; w.x = pk2(bflo(raw.x) * r0[0], bfhi(raw.x) * r0[1]); w.y = pk2(bflo(raw.y) * r0[2], bfhi(raw.y) * r0[3]);
            w.z = pk2(bflo(raw.z) * r1[0], bfhi(raw.z) * r1[1]); w.w = pk2(bflo(raw.w) * r1[2], bfhi(raw.w) * r1[3]);
            vb[s] = __builtin_bit_cast(bf16x8, w);
        }
        const float gn = sgng[c];
#pragma unroll 1
        for (int pb = 0; pb < 4; ++pb) {
            f32x16 a0;
#pragma unroll
            for (int j = 0; j < 16; ++j) a0[j] = 0.f;
#pragma unroll
            for (int s = 0; s < 8; ++s) {
                const bf16x8 wa = *(const bf16x8*)(Wg + (unsigned)((pb * 32 + r32) * 128 + 16 * s + 8 * hi));
                a0 = MFMA32(wa, vb[s], a0);
            }
            unsigned short uu[16], gg[16]; float bb[16];
#pragma unroll
            for (int j = 0; j < 16; ++j) { const int p = pb * 32 + crow(j, hi); const unsigned tok = (unsigned)t0 + p;
                uu[j] = ACT[tok * (unsigned)LDACT + A_SGU + c]; gg[j] = ACT[tok * (unsigned)LDACT + A_SGG + c]; bb[j] = sgb[g * 128 + p]; }
#pragma unroll
            for (int j = 0; j < 16; ++j) { const int p = pb * 32 + crow(j, hi); const unsigned tok = (unsigned)t0 + p;
                const float sv = a0[j] * gn + bb[j];
                YCAT[tok * (unsigned)LDY + Y_SG + c] = (bf16_t)f2bf(bf2f(uu[j]) * sv * siluf_(bf2f(gg[j]))); }
        }
    }
    __syncthreads();
}

__device__ __forceinline__ void transpose_item(const float* W, int K, int N, bf16_t* WT, int ldt, int item, int lane, LAS float* scr, bool permute) {
    const int nblk = N / 32, kb = item / nblk, nb = item % nblk, k0 = 64 * kb, n0 = 32 * nb;
#pragma unroll 8
    for (int i = 0; i < 32; ++i) { const int kk = 2 * i + (lane >> 5); scr[kk * 33 + (lane & 31)] = W[(size_t)(k0 + kk) * N + n0 + (lane & 31)]; }
    asm volatile("s_waitcnt lgkmcnt(0)" ::: "memory");
    int d0 = n0;
    if (permute) { const int s = n0 >> 9; int ds;
        if (s == 1) ds = 18; else if (s == 5) ds = 19; else if (s == 9) ds = 20; else ds = s - (s > 9 ? 3 : s > 5 ? 2 : s > 1 ? 1 : 0);
        d0 = ds * 512 + (n0 & 511); }
    const int c = lane & 7;
#pragma unroll
    for (int j = 0; j < 4; ++j) { const int n = (lane >> 3) + 8 * j; const LAS float* s = scr + (8 * c) * 33 + n;
        u32x4 o; o.x = pk2(s[0 * 33], s[1 * 33]); o.y = pk2(s[2 * 33], s[3 * 33]); o.z = pk2(s[4 * 33], s[5 * 33]); o.w = pk2(s[6 * 33], s[7 * 33]);
        *(u32x4*)(WT + (size_t)(d0 + n) * ldt + k0 + 8 * c) = o; }
    asm volatile("s_waitcnt lgkmcnt(0)" ::: "memory");
}

__device__ __forceinline__ void convert_layer_weights(int l, LAS unsigned char* lds) {
    KPARAMS;
    const int tid = ltid(), wave = tid >> 6, lane = tid & 63;
    LAS float* scr = (LAS float*)(lds + wave * 16384);
    const int gw = blockIdx.x * 8 + wave, NGW = gridDim.x * 8;
    unsigned char* ws_ = lws(P); bf16_t* WIN = (bf16_t*)(ws_ + WS_WIN); bf16_t* WP = (bf16_t*)(ws_ + WS_WP); bf16_t* WO = (bf16_t*)(ws_ + WS_WO);
    constexpr int I_IN = 16 * 336, I_P = 8 * 32, I_F = 16 * 32, I_O = 16 * 32, NIT = I_IN + 3 * I_P + I_F + I_O;
    for (int it = gw; it < NIT; it += NGW) {
        int r = it;
        if (r < I_IN) { transpose_item(P.in[I_WIN] + (size_t)l * 1024 * NIN, 1024, NIN, WIN, 1024, r, lane, scr, true); continue; } r -= I_IN;
        if (r < I_P) { transpose_item(P.in[I_PSG] + (size_t)l * 512 * 1024, 512, 1024, WP, LDY, r, lane, scr, false); continue; } r -= I_P;
        if (r < I_P) { transpose_item(P.in[I_PDIFF] + (size_t)l * 512 * 1024, 512, 1024, WP + 512, LDY, r, lane, scr, false); continue; } r -= I_P;
        if (r < I_P) { transpose_item(P.in[I_PNA] + (size_t)l * 512 * 1024, 512, 1024, WP + 1024, LDY, r, lane, scr, false); continue; } r -= I_P;
        if (r < I_F) { transpose_item(P.in[I_PFNET] + (size_t)l * 1024 * 1024, 1024, 1024, WP + 1536, LDY, r, lane, scr, false); continue; } r -= I_F;
        transpose_item(P.in[I_WOUT] + (size_t)l * 1024 * 1024, 1024, 1024, WO, 1024, r, lane, scr, false);
    }
}

__device__ __forceinline__ void p1_rows(int l) {
    KPARAMS;
    const int tid = ltid(), wave = tid >> 6, lane = tid & 63;
    const int gw = blockIdx.x * 8 + wave, NGW = gridDim.x * 8;
    const float* MOD = (const float*)(P.ws + WS_MOD);
    const bf16_t* OUTRAW = (const bf16_t*)(P.ws + WS_ACT);
    bf16_t* HB = (bf16_t*)(P.ws + WS_R1);
#pragma unroll 1
    for (int t0 = gw; t0 < TOK; t0 += 2 * NGW) {
        f32x4 x[2][4]; u32x2 rq[2][4];
        int tt[2], cvv[2];
#pragma unroll
        for (int q = 0; q < 2; ++q) { int t = t0 + q * NGW; tt[q] = t; if (t >= TOK) t = t0; cvv[q] = t < TCTX ? 0 : 1 + ((t - TCTX) >> 12);
            const float* xs = (l <= 1) ? (t < TCTX ? P.in[I_XP] + (size_t)t * DM : P.in[I_XS] + (size_t)(t - TCTX) * DM) : P.out + (size_t)t * DM;
#pragma unroll
            for (int j = 0; j < 4; ++j) x[q][j] = *(const f32x4*)(xs + 4 * lane + 256 * j);
            if (l >= 1) {
#pragma unroll
                for (int j = 0; j < 4; ++j) rq[q][j] = *(const u32x2*)(OUTRAW + (size_t)t * DM + 4 * lane + 256 * j); } }
#pragma unroll
        for (int q = 0; q < 2; ++q) { const int t = tt[q], cv = cvv[q];
            if (t >= TOK) continue;
            if (l >= 1) {
                f32x4 r[4]; float s = 0.f;
#pragma unroll
                for (int j = 0; j < 4; ++j) { const u32x2 w = rq[q][j]; r[j] = (f32x4){bflo(w.x), bfhi(w.x), bflo(w.y), bfhi(w.y)}; s += r[j][0] * r[j][0] + r[j][1] * r[j][1] + r[j][2] * r[j][2] + r[j][3] * r[j][3]; }
                const float rs = rsqrtf(wave_sum(s) * (1.0f / DM) + EPSN);
                const float* gate = MOD + ((size_t)(l - 1) * 3 + cv) * 3072 + 2048;
                const float* gp = P.in[I_GPOST] + (size_t)(l - 1) * DM;
#pragma unroll
                for (int j = 0; j < 4; ++j) { const f32x4 gt = *(const f32x4*)(gate + 4 * lane + 256 * j), gg = *(const f32x4*)(gp + 4 * lane + 256 * j);
                    x[q][j] = x[q][j] + gt * (r[j] * rs * gg);
                    *(f32x4*)(P.out + (size_t)t * DM + 4 * lane + 256 * j) = x[q][j]; }
            }
            if (l < 4) {
                float s = 0.f;
#pragma unroll
                for (int j = 0; j < 4; ++j) s += x[q][j][0] * x[q][j][0] + x[q][j][1] * x[q][j][1] + x[q][j][2] * x[q][j][2] + x[q][j][3] * x[q][j][3];
                const float rs = rsqrtf(wave_sum(s) * (1.0f / DM) + EPSN);
                const float* md = MOD + ((size_t)l * 3 + cv) * 3072;
                const float* gp = P.in[I_GPRE] + (size_t)l * DM;
#pragma unroll
                for (int j = 0; j < 4; ++j) { const int c = 4 * lane + 256 * j;
                    const f32x4 sh = *(const f32x4*)(md + c), sc = *(const f32x4*)(md + 1024 + c), gg = *(const f32x4*)(gp + c);
                    const f32x4 hh = x[q][j] * rs * gg * (sc + 1.0f) + sh;
                    u32x2 w; w.x = pk2(hh[0], hh[1]); w.y = pk2(hh[2], hh[3]);
                    *(u32x2*)(HB + (size_t)t * DM + c) = w; }
            }
        }
    }
}

__device__ __forceinline__ void prologue(LAS unsigned char* lds) {
    KPARAMS;
    const int tid = ltid(), wave = tid >> 6, lane = tid & 63;
    const size_t gt = (size_t)blockIdx.x * NTHR + tid, GT = (size_t)gridDim.x * NTHR;
    LAS float* tab = (LAS float*)lds;
    for (int k = tid; k < 4096; k += NTHR) tab[k] = cosf((float)k * (6.283185307179586f / 4096.0f)) * (1.0f / 64.0f);
    __syncthreads();
    {
        bf16_t* CSL = (bf16_t*)(P.ws + WS_CSL);
        for (size_t e = gt; e < (size_t)4096 * 512; e += GT) { const int i = (int)(e >> 9), j0 = (int)(e & 511) * 8;
            u32x4 wc, ws; unsigned* pc = (unsigned*)&wc; unsigned* ps = (unsigned*)&ws;
#pragma unroll
            for (int q = 0; q < 4; ++q) { const int i0 = (i * (j0 + 2 * q)) & 4095, i1 = (i * (j0 + 2 * q + 1)) & 4095;
                pc[q] = pk2(tab[i0], tab[i1]); ps[q] = pk2(tab[(i0 + 1024) & 4095], tab[(i1 + 1024) & 4095]); }
            *(u32x4*)(CSL + (size_t)i * 8192 + j0) = wc; *(u32x4*)(CSL + (size_t)i * 8192 + 4096 + j0) = ws; }
        bf16_t* CS256 = (bf16_t*)(P.ws + WS_CS256); bf16_t* CSP = (bf16_t*)(P.ws + WS_CSP256);
        for (size_t e = gt; e < 256 * 256; e += GT) { const int j = (int)(e >> 8), k = (int)(e & 255); const int idx = ((j * k) & 255) * 16;
            const float cv = tab[idx] * 4.0f, sv = tab[(idx + 3072) & 4095] * 4.0f;
            CS256[j * 256 + k] = (bf16_t)f2bf(cv); CS256[(256 + j) * 256 + k] = (bf16_t)f2bf(sv);
            CSP[j * 512 + k] = (bf16_t)f2bf(cv); CSP[j * 512 + 256 + k] = (bf16_t)f2bf(-sv); }
    }
    {
        float* ROPE = (float*)(P.ws + WS_ROPE);
        for (size_t e = gt; e < 64 * 16; e += GT) { const int pos = (int)(e >> 4), f = (int)(e & 15);
            const float inv = powf(10000.0f, -(float)f / 16.0f); const float ang = (float)pos * inv;
            ROPE[pos * 32 + f] = cosf(ang); ROPE[pos * 32 + 16 + f] = sinf(ang); }
        float* RPB = (float*)(P.ws + WS_RPB);
        for (size_t e = gt; e < 4 * 8 * 15 * 31; e += GT) RPB[e] = P.in[I_RPB][e] * LOG2E;
        bf16_t* SGW = (bf16_t*)(P.ws + WS_SGW);
        for (size_t e = gt; e < 4 * 8 * 128 * 128; e += GT) SGW[e] = (bf16_t)f2bf(P.in[I_SGW][e]);
    }
    {
        bf16_t* CDK = (bf16_t*)(P.ws + WS_CDK); bf16_t* CNK = (bf16_t*)(P.ws + WS_CNK);
        bf16_t* CDVT = (bf16_t*)(P.ws + WS_CDVT); bf16_t* CNVT = (bf16_t*)(P.ws + WS_CNVT);
        const size_t NC4 = (size_t)2 * 4 * 512 * 512 / 4;
        for (size_t e = gt; e < NC4; e += GT) { const f32x4 a = *(const f32x4*)(P.in[I_CDK] + 4 * e), b = *(const f32x4*)(P.in[I_CNK] + 4 * e);
            u32x2 wa, wb; wa.x = pk2(a[0], a[1]); wa.y = pk2(a[2], a[3]); wb.x = pk2(b[0], b[1]); wb.y = pk2(b[2], b[3]);
            *(u32x2*)(CDK + 4 * e) = wa; *(u32x2*)(CNK + 4 * e) = wb; }
        LAS float* tl = (LAS float*)(lds + 32768);
        const int ti = tid >> 6, tj = tid & 63;
        for (int tile = blockIdx.x; tile < 1024; tile += gridDim.x) {
            const int arr = tile >> 9, r = tile & 511, bl = r >> 6, pb = (r >> 3) & 7, fb = r & 7;
            const float* src = (arr ? P.in[I_CNV] : P.in[I_CDV]) + ((size_t)(bl * 512 + pb * 64) * 512 + fb * 64);
#pragma unroll
            for (int rr = 0; rr < 8; ++rr) { const int p = rr * 8 + ti; tl[p * 65 + tj] = src[(size_t)p * 512 + tj]; }
            __syncthreads();
            bf16_t* dst = (arr ? CNVT : CDVT) + ((size_t)(bl * 512 + fb * 64) * 512 + pb * 64);
#pragma unroll
            for (int rr = 0; rr < 8; ++rr) { const int f = rr * 8 + ti; dst[(size_t)f * 512 + tj] = (bf16_t)f2bf(tl[tj * 65 + f]); }
            __syncthreads();
        }
    }
    __syncthreads();
    {
        float* MOD = (float*)(P.ws + WS_MOD);
        LAS float* red = (LAS float*)lds;
        LAS float* sc = (LAS float*)(lds + 16384);
        for (int k = tid; k < 1024; k += NTHR) { sc[k] = siluf_(P.in[I_CCTX][k]); sc[1024 + k] = siluf_(P.in[I_C][k]); sc[2048 + k] = siluf_(P.in[I_C][1024 + k]); }
        __syncthreads();
        for (int un = blockIdx.x; un < 4 * 48; un += gridDim.x) {
            const int l = un / 48, jb = un % 48; const int j = jb * 64 + lane;
            const float* w = P.in[I_WMOD] + (size_t)l * 1024 * 3072 + j;
            float a0 = 0.f, a1 = 0.f, a2 = 0.f;
#pragma unroll 1
            for (int k0 = wave * 128; k0 < wave * 128 + 128; k0 += 16) {
                float wv[16];
#pragma unroll
                for (int i = 0; i < 16; ++i) wv[i] = w[(size_t)(k0 + i) * 3072];
#pragma unroll
                for (int i = 0; i < 16; ++i) { a0 += sc[k0 + i] * wv[i]; a1 += sc[1024 + k0 + i] * wv[i]; a2 += sc[2048 + k0 + i] * wv[i]; }
            }
            red[(wave * 3 + 0) * 64 + lane] = a0; red[(wave * 3 + 1) * 64 + lane] = a1; red[(wave * 3 + 2) * 64 + lane] = a2;
            __syncthreads();
            if (tid < 192) { const int cv = tid >> 6, ln = tid & 63; float sm = 0.f;
#pragma unroll
                for (int w8 = 0; w8 < 8; ++w8) sm += red[(w8 * 3 + cv) * 64 + ln];
                MOD[((size_t)l * 3 + cv) * 3072 + jb * 64 + ln] = sm + P.in[I_BMOD][(size_t)l * 3072 + jb * 64 + ln]; }
            __syncthreads();
        }
    }
}

__device__ __forceinline__ void combine_pf() {
    KPARAMS;
    const float* PF = (const float*)(P.ws + WS_R1); const bf16_t* ACT = (const bf16_t*)(P.ws + WS_ACT); bf16_t* YCAT = (bf16_t*)(P.ws + WS_YCAT);
    const size_t gt = (size_t)blockIdx.x * NTHR + ltid(), GT = (size_t)gridDim.x * NTHR;
    for (size_t e = gt; e < (size_t)8192 * 256; e += GT) { const size_t t = e >> 8; const int c = (int)(e & 255) * 4;
        const f32x4 a = *(const f32x4*)(PF + t * 1024 + c), b = *(const f32x4*)(PF + (size_t)8192 * 1024 + t * 1024 + c);
        const size_t tok = TCTX + t;
        const u32x2 g = *(const u32x2*)(ACT + tok * LDACT + A_FG + c);
        u32x2 w; w.x = pk2((a[0] + b[0]) * bflo(g.x), (a[1] + b[1]) * bfhi(g.x)); w.y = pk2((a[2] + b[2]) * bflo(g.y), (a[3] + b[3]) * bfhi(g.y));
        *(u32x2*)(YCAT + tok * LDY + Y_F + c) = w; }
}

constexpr size_t WS_BAR = WS_SMALL + 2 * MiB + 512 * 1024;
constexpr int LDS_BARST = LDS_BYTES - 64;
#define XB_TMO      128
#define XB_XCNT(j)  (256  + 64 * (j))
#define XB_XSUB(j)  (1280 + 64 * (j))
#define XB_XGEN(j)  (2304 + 64 * (j))
#define XB_TOP      3328
#define XB_TOPGEN   3392
#define XCD_BAR_WORDS 3456
#define XB_SPIN_CAP (1u << 20)
__device__ __forceinline__ unsigned xb_ld(unsigned* p)              { return __hip_atomic_load(p, __ATOMIC_RELAXED, __HIP_MEMORY_SCOPE_AGENT); }
__device__ __forceinline__ unsigned xb_add(unsigned* p, unsigned v) { return __hip_atomic_fetch_add(p, v, __ATOMIC_RELAXED, __HIP_MEMORY_SCOPE_AGENT); }
__device__ __forceinline__ unsigned xb_xcc_id() { return (unsigned)__builtin_amdgcn_s_getreg((3 << 11) | 20) & 0xFu; }
#define XB_SPIN(cond, bar) do { unsigned _sp = 0; while (cond) { __builtin_amdgcn_s_sleep(1); \
    if ((++_sp & 255u) == 0u) { if (xb_ld(&(bar)[XB_TMO])) break; if (_sp > XB_SPIN_CAP) { atomicAdd(&(bar)[XB_TMO], 1u); break; } } } } while (0)
__device__ __forceinline__ void xcd_barrier_complete(unsigned* bar, unsigned x, unsigned& nloc, unsigned& nx) {
    const unsigned G = gridDim.x;
    unsigned sum, cnt, mine, sp = 0u;
    for (;;) {
        sum = 0u; cnt = 0u; mine = 0u;
#pragma unroll
        for (unsigned j = 0; j < 16; ++j) { const unsigned c = xb_ld(&bar[XB_XCNT(j)]); sum += c; cnt += (c > 0u) ? 1u : 0u; mine = (j == x) ? c : mine; }
        if (sum == G) break;
        __builtin_amdgcn_s_sleep(1);
        if ((++sp & 255u) == 0u) { if (xb_ld(&bar[XB_TMO])) break; if (sp > XB_SPIN_CAP) { atomicAdd(&bar[XB_TMO], 1u); break; } }
    }
    nloc = mine > 0u ? mine : 1u; nx = cnt > 0u ? cnt : 1u;
}
__device__ __forceinline__ void gbar(LAS unsigned char* lds) {
    KPARAMS;
    asm volatile("s_waitcnt vmcnt(0)" ::: "memory");
    __syncthreads();
    if (threadIdx.x == 0) {
        unsigned* bar = (unsigned*)(lws(P) + WS_BAR);
        volatile LAS unsigned* st = (volatile LAS unsigned*)(lds + LDS_BARST);
        const unsigned x = xb_xcc_id();
        __builtin_amdgcn_s_waitcnt(0);
        unsigned nloc = st[0], nx = st[1];
        if (nloc == 0u) { xcd_barrier_complete(bar, x, nloc, nx); st[0] = nloc; st[1] = nx; }
        const unsigned old = xb_add(&bar[XB_XSUB(x)], 1u);
        const unsigned gen = old / nloc;
        if (old + 1u == (gen + 1u) * nloc) {
            __builtin_amdgcn_fence(__ATOMIC_RELEASE, "agent");
            asm volatile("s_waitcnt vmcnt(0)" ::: "memory");
            const unsigned og = xb_add(&bar[XB_TOP], 1u);
            const unsigned tg = og / nx;
            if (og + 1u == (tg + 1u) * nx) xb_add(&bar[XB_TOPGEN], 1u);
            else XB_SPIN(xb_ld(&bar[XB_TOPGEN]) == tg, bar);
            __builtin_amdgcn_fence(__ATOMIC_ACQUIRE, "agent");
            xb_add(&bar[XB_XGEN(x)], 1u);
            asm volatile("s_waitcnt vmcnt(0)" ::: "memory");
        } else {
            XB_SPIN(xb_ld(&bar[XB_XGEN(x)]) == gen, bar);
            __builtin_amdgcn_fence(__ATOMIC_ACQUIRE, "agent");
            asm volatile("s_waitcnt vmcnt(0)" ::: "memory");
        }
    }
    __syncthreads();
}

#ifndef REP_P2
#define REP_P2 1
#endif
#ifndef REP_DFT
#define REP_DFT 1
#endif
#ifndef REP_DL
#define REP_DL 1
#endif
#ifndef REP_AR
#define REP_AR 1
#endif
#ifndef REP_P4
#define REP_P4 1
#endif
#ifndef REP_P5
#define REP_P5 1
#endif
#ifndef REP_CONV
#define REP_CONV 1
#endif

struct EpiC { static constexpr bool HOOK = false; EpiCdft e; __device__ __forceinline__ void operator()(EPI_ARGS) const { Unit v = u; v.pm = u.x * 2 + u.pm; e(acc, v, wr, wc, fr, fq); } };
__device__ __forceinline__ void phase2(int l, LAS unsigned char* lds) {
    KPARAMS;
    unsigned char* ws = lws(P); const int G = gridDim.x, bid = lbid();
    bf16_t* WIN = (bf16_t*)(ws + WS_WIN); bf16_t* HB = (bf16_t*)(ws + WS_R1); bf16_t* ACT = (bf16_t*)(ws + WS_ACT); bf16_t* XT = (bf16_t*)(ws + WS_R3);
#pragma unroll 1
    for (int step = 0; step < 3; ++step) {
        const int which = (bid >= (G >> 1)) ? (step == 0 ? 2 : step - 1) : step;
        if (which == 0) {
            Job J{HB, WIN, 1024, 1024, 1024, 64, 36, 1, G, bid, 256L * 1024, 0, 0, 0, 256L * 1024, 0, 1};
            EpiIn E{ACT, P.out + (size_t)1 * 16777216, P.out + (size_t)3 * 16777216, (const float*)(ws + WS_ROPE), l, (bf16_t*)(ws + WS_GF)};
            pg8::gemm_phase(lds, J, E);
        } else if (which == 1) {
            Job J{WIN + (size_t)9216 * 1024, HB, 1024, 1024, 1024, 6, 64, 1, G, bid, 256L * 1024, 0, 0, 0, 256L * 1024, 0, 0};
            EpiInT E{XT, P.out + (size_t)2 * 16777216, P.out + (size_t)4 * 16777216, l};
            pg8::gemm_phase(lds, J, E);
        } else {
            const int hG = G >> 1;
            if (bid >= hG) {
            Job J{(const bf16_t*)(ws + WS_CS256), HB, 256, 1024, 256, 2, 64, 4, hG, bid - hG, 256L * 256, 0, 0, 0, 256L * 1024, 256, 0};
            EpiC E{{(bf16_t*)(ws + WS_R2), (bf16_t*)(ws + WS_R2 + 32 * MiB)}};
            pg8::gemm_phase(lds, J, E);
            }
        }
    }
}

__device__ __forceinline__ void phase3_dft(int l, LAS unsigned char* lds) {
    KPARAMS;
    unsigned char* ws = lws(P); const int G = gridDim.x, bid = lbid(), hG = G >> 1;
    if (bid < hG) {
        Job J{(const bf16_t*)(ws + WS_CSL), (const bf16_t*)(ws + WS_R2 + 32 * MiB), 8192, 8192, 8192, 16, 4, 2, hG, bid, 256L * 8192, 0, 0, 0, 256L * 8192, 1024L * 8192, 0};
        EpiPdftCtx E{(const bf16_t*)(ws + WS_GF), (bf16_t*)(ws + WS_YCAT), TCTX, 4096};
        pg8::gemm_phase(lds, J, E);
    } else {
        Job J{(const bf16_t*)(ws + WS_CSP256), (const bf16_t*)(ws + WS_R2), 512, 512, 512, 1, 4, 32, G - hG, bid - hG, 0, 0, 0, 0, 256L * 512, 1024L * 512, 0};
        EpiPdftCtx E{(const bf16_t*)(ws + WS_GF), (bf16_t*)(ws + WS_YCAT), 0, 256};
        pg8::gemm_phase(lds, J, E);
    }
}

__device__ __forceinline__ void na_unit(int l, int id, LAS unsigned char* lds) {
    KPARAMS;
    unsigned char* ws = lws(P);
    const bf16_t* ACT = (const bf16_t*)(ws + WS_ACT); const bf16_t* XT = (const bf16_t*)(ws + WS_R3); bf16_t* YCAT = (bf16_t*)(ws + WS_YCAT);
    const int tid = ltid(), wid = __builtin_amdgcn_readfirstlane(tid >> 6), lane = tid & 63, r32 = lane & 31, hi = lane >> 5;
        const int xc = id & 7, jj = id >> 3, b = xc >> 2, hg = (xc >> 1) & 1, r = (xc & 1) * 32 + jj;
        const int r0 = min(max(r - 4, 0), 56);
        const size_t base = TCTX + (size_t)b * 4096;
        KVSrc S{ACT + (base + (size_t)r0 * 64) * LDACT + A_NK + hg * 256, LDACT, XT + (size_t)(1024 + hg * 256) * TOK + base + (size_t)r0 * 64, TOK, 8,
                (const bf16_t*)(ws + WS_CNK) + ((size_t)(b * 4 + l) * 512) * 512 + hg * 256, 512, (const bf16_t*)(ws + WS_CNVT) + ((size_t)(b * 4 + l) * 512 + hg * 256) * 512, 512};
        const int hl = wid >> 1, qh = wid & 1, h = hg * 4 + hl, qc = qh * 32 + r32;
        const size_t tok = base + (size_t)r * 64 + qc;
        f32x16 o[2]; float lsum;
        LAS float* rpbl = (LAS float*)(lds + 141312);
        { const float* rsrc = (const float*)(ws + WS_RPB) + (size_t)(l * 8 + hg * 4) * 15 * 31;
          for (int i = tid; i < 4 * 15 * 31; i += NTHR) rpbl[i] = rsrc[i]; }
        attn_core<64, 256, 2, 2>(lds, ACT + tok * LDACT + A_NQ + h * 64, S, 16, hl * 64, hl * 64, rpbl + hl * 15 * 31, r0 - r, qc, o, lsum);
        attn_store64(o, lsum, ACT + tok * LDACT + A_NG + h * 64, YCAT + tok * LDY + Y_NA + h * 64, hi);
}

__device__ __forceinline__ void phase3_attn_a(int l, LAS unsigned char* lds) {
    KPARAMS;
    unsigned char* ws = lws(P); const int G = gridDim.x, bid = lbid();
    const bf16_t* ACT = (const bf16_t*)(ws + WS_ACT); const bf16_t* XT = (const bf16_t*)(ws + WS_R3); bf16_t* YCAT = (bf16_t*)(ws + WS_YCAT);
    const int tid = ltid(), wid = __builtin_amdgcn_readfirstlane(tid >> 6), lane = tid & 63, r32 = lane & 31, hi = lane >> 5;
    const float lam_init = 0.8f - 0.6f * expf(-0.3f * (float)l);
    const float d1 = wave_sum(P.in[I_LQ1][l * 64 + lane] * P.in[I_LK1][l * 64 + lane]);
    const float d2 = wave_sum(P.in[I_LQ2][l * 64 + lane] * P.in[I_LK2][l * 64 + lane]);
    const float lam = expf(d1) - expf(d2) + lam_init;
    const float* subln = P.in[I_SUBLN] + l * 128;
#pragma unroll 1
    for (int rp = 0; rp < REP_AR; ++rp) {
    if (bid >= (G >> 1)) {
#pragma unroll 1
        for (int id = bid - (G >> 1); id < 256; id += G - (G >> 1)) na_unit(l, id, lds);
    }
    for (int id = bid; id < 256; id += G) {
        const int b = id >> 3, h = (id >> 1) & 3, qh = id & 1;
        const size_t base = (size_t)b * 256;
        KVSrc S{ACT + base * LDACT + A_DK + h * 128, LDACT, XT + (size_t)(512 + h * 128) * TOK + base, TOK, 4, nullptr, 0, nullptr, 0};
        diff_unit(lds, ACT, YCAT, S, 4, base + (size_t)qh * 128, h, lam, lam_init, subln);
    }
    for (int id = bid; id < 256; id += G) {
        const int b = id >> 3, h = id & 7;
        const size_t base = (size_t)b * 256;
        KVSrc S{ACT + base * LDACT + A_NK + h * 64, LDACT, XT + (size_t)(1024 + h * 64) * TOK + base, TOK, 4, nullptr, 0, nullptr, 0};
        const size_t tok = base + wid * 32 + r32;
        f32x16 o[2]; float lsum;
        attn_core<64, 64, 0, 3>(lds, ACT + tok * LDACT + A_NQ + h * 64, S, 4, 0, 0, nullptr, 0, 0, o, lsum);
        attn_store64(o, lsum, ACT + tok * LDACT + A_NG + h * 64, YCAT + tok * LDY + Y_NA + h * 64, hi);
    }
    for (int id = G - 1 - bid; id < 128; id += G)
        spatial_unit(lds, id, ACT, XT, (const bf16_t*)(ws + WS_SGW) + (size_t)l * 8 * 128 * 128, P.in[I_SGB] + l * 1024, P.in[I_SGNG] + l * 512, YCAT);
    }
}

__device__ __forceinline__ void phase3_attn_b(int l, LAS unsigned char* lds) {
    KPARAMS;
    unsigned char* ws = lws(P); const int G = gridDim.x, bid = lbid();
    const bf16_t* ACT = (const bf16_t*)(ws + WS_ACT); const bf16_t* XT = (const bf16_t*)(ws + WS_R3); bf16_t* YCAT = (bf16_t*)(ws + WS_YCAT);
    const int tid = ltid(), wid = __builtin_amdgcn_readfirstlane(tid >> 6), lane = tid & 63, r32 = lane & 31, hi = lane >> 5;
    const float lam_init = 0.8f - 0.6f * expf(-0.3f * (float)l);
    const float d1 = wave_sum(P.in[I_LQ1][l * 64 + lane] * P.in[I_LK1][l * 64 + lane]);
    const float d2 = wave_sum(P.in[I_LQ2][l * 64 + lane] * P.in[I_LK2][l * 64 + lane]);
    const float lam = expf(d1) - expf(d2) + lam_init;
    const float* subln = P.in[I_SUBLN] + l * 128;
#pragma unroll 1
    for (int rp = 0; rp < REP_DL; ++rp)
    for (int id = bid; id < 256; id += G) {
        const int bh = id & 7, qb = id >> 3, b = bh >> 2, h = bh & 3;
        const size_t base = TCTX + (size_t)b * 4096;
        KVSrc S{ACT + base * LDACT + A_DK + h * 128, LDACT, XT + (size_t)(512 + h * 128) * TOK + base, TOK, 64,
                (const bf16_t*)(ws + WS_CDK) + ((size_t)(b * 4 + l) * 512) * 512 + h * 128, 512, (const bf16_t*)(ws + WS_CDVT) + ((size_t)(b * 4 + l) * 512 + h * 128) * 512, 512};
        diff_unit(lds, ACT, YCAT, S, 72, base + (size_t)qb * 128, h, lam, lam_init, subln);
    }
}

__device__ __forceinline__ void phase_mix(LAS unsigned char* lds) {
    KPARAMS;
    unsigned char* ws = lws(P); const int G = gridDim.x, bid = lbid();
    Job J{(const bf16_t*)(ws + WS_YCAT), (const bf16_t*)(ws + WS_WP), LDY, LDY, LDY, 64, 4, 1, G, bid, 256L * LDY, 0, 0, 0, 256L * LDY, 0, 1};
    EpiMix E{(const bf16_t*)(ws + WS_GF), (bf16_t*)(ws + WS_R3)};
    pg8::gemm_phase(lds, J, E);
}

__device__ __forceinline__ void phase5(LAS unsigned char* lds) {
    KPARAMS;
    unsigned char* ws = lws(P); const int G = gridDim.x, bid = lbid();
    Job J{(const bf16_t*)(ws + WS_R3), (const bf16_t*)(ws + WS_WO), 1024, 1024, 1024, 64, 4, 1, G, bid, 256L * 1024, 0, 0, 0, 256L * 1024, 0, 1};
    EpiOut E{(bf16_t*)(ws + WS_ACT)};
    pg8::gemm_phase(lds, J, E);
}

__global__ void __launch_bounds__(NTHR, 2) fwd_megakernel(Params P) {
    extern __shared__ __attribute__((aligned(16))) unsigned char smem[];
    LAS unsigned char* lds = (LAS unsigned char*)smem;
    cg::grid_group grid = cg::this_grid();
    if (threadIdx.x < 16) ((LAS unsigned*)(lds + LDS_BARST))[threadIdx.x] = 0u;
    if (blockIdx.x == 0) { unsigned* bar = (unsigned*)(P.ws + WS_BAR); for (int i = threadIdx.x; i < XCD_BAR_WORDS; i += NTHR) __hip_atomic_store(bar + i, 0u, __ATOMIC_RELAXED, __HIP_MEMORY_SCOPE_AGENT); }
    prologue(lds);
    grid.sync();
    if (threadIdx.x == 0) (void)xb_add((unsigned*)(P.ws + WS_BAR) + XB_XCNT(xb_xcc_id()), 1u);
#pragma unroll 1
    for (int l = 0; l < 4; ++l) {
#pragma unroll 1
        for (int rp = 0; rp < REP_CONV; ++rp) convert_layer_weights(l, lds);
        p1_rows(l);
        gbar(lds);
#pragma unroll 1
        for (int rp = 0; rp < REP_P2; ++rp) phase2(l, lds);
        gbar(lds);
#pragma unroll 1
        for (int rp = 0; rp < REP_DFT; ++rp) phase3_dft(l, lds);
        phase3_attn_a(l, lds);
        phase3_attn_b(l, lds);
        gbar(lds);
#pragma unroll 1
        for (int rp = 0; rp < REP_P4; ++rp) {
        if (rp) gbar(lds);
        phase_mix(lds);
        gbar(lds);
        }
#pragma unroll 1
        for (int rp = 0; rp < REP_P5; ++rp) phase5(lds);
        gbar(lds);
    }
    p1_rows(4);
}

extern "C" void kernel_launch(void* const* d_in, const int* in_sizes, int n_in, void* d_out, int out_size, void* d_ws, size_t ws_size, hipStream_t stream) {
    static int grid = 0;
    if (grid == 0) {
        if (n_in != 27 || ws_size < WS_END) { fprintf(stderr, "kernel_launch: unexpected n_in %d or ws_size %zu (< %zu)\n", n_in, ws_size, (size_t)WS_END); grid = -1; return; }
        int dev = 0, cus = 0, per_cu = 0;
        hipGetDevice(&dev);
        hipDeviceGetAttribute(&cus, hipDeviceAttributeMultiprocessorCount, dev);
        hipFuncSetAttribute((const void*)fwd_megakernel, hipFuncAttributeMaxDynamicSharedMemorySize, LDS_BYTES);
        hipOccupancyMaxActiveBlocksPerMultiprocessor(&per_cu, (const void*)fwd_megakernel, NTHR, LDS_BYTES);
        if (per_cu < 1) { fprintf(stderr, "kernel_launch: occupancy query says %d blocks/CU\n", per_cu); per_cu = 1; }
        (void)hipGetLastError();
        grid = cus;
    }
    if (grid < 0) return;
    Params p{};
    for (int i = 0; i < 27; ++i) p.in[i] = (const float*)d_in[i];
    p.out = (float*)d_out; p.ws = (unsigned char*)d_ws;
    void* args[] = {&p};
    hipError_t e = hipLaunchCooperativeKernel((const void*)fwd_megakernel, dim3(grid), dim3(NTHR), args, LDS_BYTES, stream);
    if (e != hipSuccess) fprintf(stderr, "cooperative launch failed: %s (grid %d)\n", hipGetErrorString(e), grid);
}
```

```cpp
#include <hip/hip_runtime.h>
#include <hip/hip_cooperative_groups.h>
#include <cstdio>
#include <cstdint>
namespace cg = cooperative_groups;

#define LAS __attribute__((address_space(3)))
typedef unsigned short bf16_t;
typedef short bf16x8 __attribute__((ext_vector_type(8)));
typedef short s16x4 __attribute__((ext_vector_type(4)));
typedef float f32x4 __attribute__((ext_vector_type(4)));
typedef float f32x16 __attribute__((ext_vector_type(16)));
typedef unsigned u32x4 __attribute__((ext_vector_type(4)));
typedef unsigned u32x2 __attribute__((ext_vector_type(2)));

constexpr int DM = 1024, TOK = 16384, TCTX = 8192, NIN = 10752, LDACT = 4160, LDY = 2560;
constexpr int GF_TILES = 20, GF_TILE = 65536;
constexpr int A_SGU = 0, A_SGG = 512, A_DQ = 1024, A_DK = 1536, A_DG = 2048, A_NQ = 2560, A_NK = 3072, A_NG = 3584, A_FG = 4096, A_MG = 5120;
constexpr int Y_SG = 0, Y_D = 512, Y_NA = 1024, Y_F = 1536;
constexpr float EPSN = 1e-6f;
constexpr float QSCALE = 0.125f * 1.4426950408889634f;
constexpr float LOG2E = 1.4426950408889634f;
constexpr int NTHR = 512;
constexpr int LDS_BYTES = 155648;

constexpr size_t MiB = 1u << 20;
constexpr size_t WS_WIN = 0;
constexpr size_t WS_WP = 21 * MiB;
constexpr size_t WS_WO = 26 * MiB;
constexpr size_t WS_CSL = 28 * MiB;
constexpr size_t WS_CDK = 92 * MiB, WS_CDVT = 96 * MiB, WS_CNK = 100 * MiB, WS_CNVT = 104 * MiB;
constexpr size_t WS_SMALL = 108 * MiB;
constexpr size_t WS_CS256 = WS_SMALL, WS_CSP256 = WS_SMALL + 256 * 1024, WS_ROPE = WS_SMALL + 512 * 1024, WS_RPB = WS_SMALL + 576 * 1024,
                 WS_MOD = WS_SMALL + 704 * 1024, WS_SGW = WS_SMALL + 1 * MiB;
constexpr size_t WS_ACT = 112 * MiB;
constexpr size_t WS_GF = WS_ACT + 132 * MiB;
constexpr size_t WS_R1 = 432 * MiB;
constexpr size_t WS_R2 = 464 * MiB;
constexpr size_t WS_R3 = 528 * MiB;
constexpr size_t WS_YCAT = 576 * MiB;
constexpr size_t WS_END = 656 * MiB;

struct Params {
    const float* in[27];
    float* out;
    unsigned char* ws;
};
typedef const __attribute__((address_space(4))) Params* KP;
enum { I_XP = 0, I_XS, I_CDK, I_CDV, I_CNK, I_CNV, I_C, I_CCTX, I_WMOD, I_BMOD, I_GPRE, I_GPOST, I_WIN, I_SGNG, I_SGW, I_SGB,
       I_LQ1, I_LK1, I_LQ2, I_LK2, I_SUBLN, I_RPB, I_PSG, I_PDIFF, I_PNA, I_PFNET, I_WOUT };

__device__ __forceinline__ unsigned f2bf(float f) { unsigned u = __builtin_bit_cast(unsigned, f); return (u + 0x7fffu + ((u >> 16) & 1u)) >> 16; }
typedef float f32x2_t __attribute__((ext_vector_type(2))); typedef __bf16 bf16x2_t __attribute__((ext_vector_type(2)));
__device__ __forceinline__ unsigned pk2(float lo, float hi) { f32x2_t v = {lo, hi}; bf16x2_t b = __builtin_convertvector(v, bf16x2_t); return __builtin_bit_cast(unsigned, b); }
__device__ __forceinline__ float bf2f(unsigned short b) { return __builtin_bit_cast(float, (unsigned)b << 16); }
__device__ __forceinline__ float bflo(unsigned w) { return __builtin_bit_cast(float, w << 16); }
__device__ __forceinline__ float bfhi(unsigned w) { return __builtin_bit_cast(float, w & 0xffff0000u); }
__device__ __forceinline__ float wave_sum(float v) {
#pragma unroll
    for (int o = 1; o < 64; o <<= 1) v += __shfl_xor(v, o);
    return v;
}
constexpr float LOG2E_ = 1.4426950408889634f;
__device__ __forceinline__ float fexp2(float x) { return __builtin_amdgcn_exp2f(x); }
__device__ __forceinline__ float sigmoidf_(float x) { return __builtin_amdgcn_rcpf(1.0f + __builtin_amdgcn_exp2f(-LOG2E_ * x)); }
__device__ __forceinline__ float einvsig_(float x) { return 1.0f + __builtin_amdgcn_exp2f(-LOG2E_ * x); }
__device__ __forceinline__ float siluf_(float x) { return x * __builtin_amdgcn_rcpf(1.0f + __builtin_amdgcn_exp2f(-LOG2E_ * x)); }
__device__ __forceinline__ int ltid() { int t = threadIdx.x; asm volatile("" : "+v"(t)); return t; }
#if defined(__HIP_DEVICE_COMPILE__)
__device__ __forceinline__ KP kparams() { KP p = (KP)__builtin_amdgcn_kernarg_segment_ptr(); asm volatile("" : "+s"(p)); return p; }
#endif
#if defined(__HIP_DEVICE_COMPILE__)
#define KPARAMS const KP PP = kparams(); const Params P = *PP
#else
#define KPARAMS const Params P{}
#endif
__device__ __forceinline__ unsigned char* lws(const Params& P) { unsigned char* w = P.ws; asm volatile("" : "+s"(w)); return w; }
__device__ __forceinline__ int lbid() { int b = blockIdx.x; asm volatile("" : "+s"(b)); return b; }
__device__ __forceinline__ unsigned gf_off(int wr, int wc, int ai, int m, int bj, int lane) { return (((((unsigned)(wr * 4 + wc) * 2 + ai) * 4 + m) * 2 + bj) * 64 + lane) * 8u; }
__device__ __forceinline__ int crow(int r, int hi) { return (r & 3) + 8 * (r >> 2) + 4 * hi; }

namespace pg8 {
constexpr int BM = 256, BK = 64, HALF = 128, HTB = HALF * BK * 2, STAGE_BYTES = 8 * HTB;
__device__ __forceinline__ int lds_byte(int r, int c) { const int st = (r >> 4) * 2 + (c >> 5), rr = r & 15, cc = c & 31, ob = rr * 64 + cc * 2; return st * 1024 + (ob ^ (((ob >> 9) & 1) << 5)); }
__device__ __forceinline__ int perm32(int rho) { const int n = rho >> 4, i = rho & 15; return 8 * (i >> 2) + 4 * n + (i & 3); }
__device__ __forceinline__ void stage_rc(int b, int& R, int& C) { const int st = b / 1024, sb = b % 1024, swz = sb ^ (((sb >> 9) & 1) << 5); R = (st >> 1) * 16 + swz / 64; C = (st & 1) * 32 + (swz % 64) / 2; }
struct Unit { int pm, pn, x; };

template <class Job, class Epi>
__device__ __forceinline__ void gemm_phase(LAS unsigned char* lds, const Job& J, const Epi& E) {
    const int tid = ltid(), wid = __builtin_amdgcn_readfirstlane(tid >> 6), lane = tid & 63, wr = wid >> 2, wc = wid & 3, fr = lane & 15, fq = lane >> 4;
    const int K = J.K, nt = K / BK;
    unsigned voffA[2], voffB[2];
#pragma unroll
    for (int i = 0; i < 2; ++i) { int R, C; stage_rc(tid * 16 + i * 8192, R, C);
        const int Rb = (R & ~31) + perm32(R & 31);
        voffA[i] = (unsigned)(R * J.lda + C) * 2u; voffB[i] = (unsigned)(Rb * J.ldb + C) * 2u; }
    const size_t kstep = (size_t)(BK * 2);
    const size_t hstepA = (size_t)HALF * J.lda * 2, hstepB = (size_t)HALF * J.ldb * 2;
    const unsigned ldsw = (unsigned)wid * 1024u;
    const int aoff = lds_byte(wr * 64 + fr, fq * 8), boff = lds_byte(wc * 32 + fr, fq * 8);
#define PG8_SA(b, h) (((b) * 2 + (h)) * HTB)
#define PG8_SB(b, h) ((4 + (b) * 2 + (h)) * HTB)
#define PG8_STAGE(bufoff, gbase, voff) do { _Pragma("unroll") for (int _i = 0; _i < 2; ++_i) \
        __builtin_amdgcn_global_load_lds((const unsigned*)((const char*)(gbase) + (voff)[_i]), (LAS unsigned*)(lds + (bufoff) + ldsw + _i * 8192), 16, 0, 0); } while (0)
#define PG8_LDA(dst, b, h) do { _Pragma("unroll") for (int m = 0; m < 4; ++m) _Pragma("unroll") for (int k = 0; k < 2; ++k) dst[m][k] = *(const LAS bf16x8*)(lds + PG8_SA(b, h) + aoff + m * 2048 + k * 1024); } while (0)
#define PG8_LDB(dst, b, h) do { _Pragma("unroll") for (int n = 0; n < 2; ++n) _Pragma("unroll") for (int k = 0; k < 2; ++k) dst[n][k] = *(const LAS bf16x8*)(lds + PG8_SB(b, h) + boff + n * 2048 + k * 1024); } while (0)
#define PG8_MMA(ai, bj, At, Bt) do { __builtin_amdgcn_s_setprio(1); _Pragma("unroll") for (int m = 0; m < 4; ++m) _Pragma("unroll") for (int n = 0; n < 2; ++n) _Pragma("unroll") for (int k = 0; k < 2; ++k) \
        acc[ai][bj][m][n] = __builtin_amdgcn_mfma_f32_16x16x32_bf16(Bt[n][k], At[m][k], acc[ai][bj][m][n], 0, 0, 0); __builtin_amdgcn_s_setprio(0); } while (0)
#define PG8_WAIT_V(n) asm volatile("s_waitcnt vmcnt(" #n ")" ::: "memory")
#define PG8_WAIT_L(n) asm volatile("s_waitcnt lgkmcnt(" #n ")" ::: "memory")
#define PG8_BAR __builtin_amdgcn_s_barrier()
#define PG8_SCHED __builtin_amdgcn_sched_barrier(0)
    Unit cur, nxt; int ui = 0;
    if (!J.next(0, cur)) return;
    f32x4 acc[2][2][4][2];
#pragma unroll
    for (int a = 0; a < 2; ++a)
#pragma unroll
        for (int b = 0; b < 2; ++b)
#pragma unroll
            for (int m = 0; m < 4; ++m)
#pragma unroll
                for (int n = 0; n < 2; ++n) acc[a][b][m][n] = (f32x4){0.f, 0.f, 0.f, 0.f};
    bf16x8 At[4][2], B0[2][2], B1[2][2];
    const char* cA; const char* cB;
    J.ptrs(cur, cA, cB);
    PG8_STAGE(PG8_SB(0, 0), cB, voffB); PG8_STAGE(PG8_SB(0, 1), cB + hstepB, voffB); PG8_STAGE(PG8_SA(0, 0), cA, voffA); PG8_STAGE(PG8_SA(0, 1), cA + hstepA, voffA);
    if (wr == 1) PG8_BAR;
    PG8_WAIT_V(2); PG8_BAR;
    PG8_STAGE(PG8_SB(1, 0), cB + kstep, voffB); PG8_STAGE(PG8_SA(1, 0), cA + kstep, voffA); PG8_STAGE(PG8_SB(1, 1), cB + hstepB + kstep, voffB);
    PG8_WAIT_V(6); PG8_BAR;
    for (;;) {
        const bool has_next = J.next(ui + 1, nxt);
        const char* nA = cA; const char* nB = cB;
        if (has_next) J.ptrs(nxt, nA, nB);
        for (int t = 0; t < nt; t += 2) {
            if constexpr (Epi::HOOK) { if (E.want(t)) E.hook(acc, cur, t, wr, wc, fr, fq); }
            const bool last = (t == nt - 2);
            const char* a1 = cA + (size_t)(t + 1) * kstep;
            const char* a2 = last ? nA : cA + (size_t)(t + 2) * kstep; const char* b2 = last ? nB : cB + (size_t)(t + 2) * kstep;
            const char* a3 = a2 + kstep; const char* b3 = b2 + kstep;
            PG8_LDB(B0, 0, 0); PG8_LDB(B1, 0, 1); PG8_SCHED; PG8_LDA(At, 0, 0); PG8_STAGE(PG8_SA(1, 1), a1 + hstepA, voffA);
            PG8_WAIT_V(8); PG8_WAIT_L(0); PG8_BAR; PG8_MMA(0, 0, At, B0); PG8_MMA(0, 1, At, B1); PG8_BAR; PG8_SCHED;
            PG8_LDA(At, 0, 1); PG8_STAGE(PG8_SB(0, 0), b2, voffB); PG8_STAGE(PG8_SB(0, 1), b2 + hstepB, voffB); PG8_STAGE(PG8_SA(0, 0), a2, voffA);
            PG8_WAIT_V(8); PG8_WAIT_L(0); PG8_BAR; PG8_MMA(1, 0, At, B0); PG8_MMA(1, 1, At, B1); PG8_BAR; PG8_SCHED;
            PG8_LDB(B0, 1, 0); PG8_LDB(B1, 1, 1); PG8_SCHED; PG8_LDA(At, 1, 0); PG8_STAGE(PG8_SA(0, 1), a2 + hstepA, voffA);
            PG8_WAIT_V(8); PG8_WAIT_L(0); PG8_BAR; PG8_MMA(0, 0, At, B0); PG8_MMA(0, 1, At, B1); PG8_BAR; PG8_SCHED;
            PG8_LDA(At, 1, 1); PG8_STAGE(PG8_SB(1, 0), b3, voffB); PG8_STAGE(PG8_SB(1, 1), b3 + hstepB, voffB); PG8_STAGE(PG8_SA(1, 0), a3, voffA);
            PG8_WAIT_V(8); PG8_WAIT_L(0); PG8_BAR; PG8_MMA(1, 0, At, B0); PG8_MMA(1, 1, At, B1); PG8_BAR; PG8_SCHED;
        }
        if (wr == 0) PG8_BAR;
        { int fr_ = fr, fq_ = fq; asm volatile("" : "+v"(fr_), "+v"(fq_));
          E(acc, cur, wr, wc, fr_, fq_); }
        if (!has_next) break;
#pragma unroll
        for (int a = 0; a < 2; ++a)
#pragma unroll
            for (int b = 0; b < 2; ++b)
#pragma unroll
                for (int m = 0; m < 4; ++m)
#pragma unroll
                    for (int n = 0; n < 2; ++n) acc[a][b][m][n] = (f32x4){0.f, 0.f, 0.f, 0.f};
        cur = nxt; cA = nA; cB = nB; ++ui;
        if (wr == 1) PG8_BAR;
    }
    PG8_WAIT_V(0);
    PG8_BAR;
#undef PG8_SA
#undef PG8_SB
#undef PG8_STAGE
#undef PG8_LDA
#undef PG8_LDB
#undef PG8_MMA
#undef PG8_WAIT_V
#undef PG8_WAIT_L
#undef PG8_BAR
#undef PG8_SCHED
}
}
using pg8::Unit;

struct Job {
    const bf16_t* A; const bf16_t* B; int lda, ldb, K;
    int nM, nN, nX, G, c;
    long sAm, sAn, sAx, sBm, sBn, sBx;
    int order;
    __device__ __forceinline__ bool next(int i, Unit& u) const {
        const int L = i * G + c; const int per = nM * nN;
        if (L >= per * nX) return false;
        const int x = L / per; int r = L - x * per;
        u.x = x;
        if (order == 1) {
            { const int q = per / 8, rr = per % 8, xcd = r % 8, off = r / 8; r = (xcd < rr ? xcd * (q + 1) : rr * (q + 1) + (xcd - rr) * q) + off; }
            const int nig = 8 * nN, gid = r / nig, fm = gid * 8, gsz = (nM - fm) < 8 ? (nM - fm) : 8;
            u.pm = fm + ((r % nig) % gsz); u.pn = (r % nig) / gsz;
        } else { u.pm = r % nM; u.pn = r / nM; }
        return true;
    }
    __device__ __forceinline__ void ptrs(const Unit& u, const char*& a, const char*& b) const {
        a = (const char*)(A + (long)u.pm * sAm + (long)u.pn * sAn + (long)u.x * sAx);
        b = (const char*)(B + (long)u.pm * sBm + (long)u.pn * sBn + (long)u.x * sBx);
    }
};

#define EPI_ARGS const f32x4 (&acc)[2][2][4][2], const Unit& u, int wr, int wc, int fr, int fq

struct EpiIn {
    static constexpr bool HOOK = false;
    bf16_t* ACT; float* out_dk; float* out_nk; const float* rope; int layer; bf16_t* GF;
    __device__ __forceinline__ void operator()(EPI_ARGS) const {
        const int seg = u.pn >> 1; const bool lat = u.pm >= 32;
        int pm_ = u.pm, pn_ = u.pn; asm volatile("" : "+s"(pm_), "+s"(pn_));
        bf16_t* gft = (seg >= 8) ? GF + (size_t)(pm_ * GF_TILES + (pn_ - 16)) * GF_TILE : nullptr;
        const int bstride = (seg >= 8) ? 512 : 128;
        int mode = 0;
        if (seg == 8 || seg == 9) mode = 1;
        else if (seg >= 10) mode = 2;
        else if (seg == 2 || seg == 5) mode = 3;
        const bool dorope = lat && (seg == 2 || seg == 3);
        float* fo = nullptr;
        if (!lat && seg == 3) fo = out_dk; else if (!lat && seg == 6) fo = out_nk;
        const int cq = wc * 32 + 8 * fq;
#pragma unroll
        for (int ai = 0; ai < 2; ++ai)
#pragma unroll
            for (int m = 0; m < 4; ++m) {
                const int rt = ai * 128 + wr * 64 + m * 16 + fr;
                const size_t row = (size_t)u.pm * 256 + rt;
                bf16_t* arow = gft ? gft + gf_off(wr, wc, ai, m, 0, fr + 16 * fq) : ACT + row * LDACT + (size_t)u.pn * 256 + cq;
                f32x4 cs0 = {1.f, 1.f, 1.f, 1.f}, cs1 = cs0, sn0 = {0.f, 0.f, 0.f, 0.f}, sn1 = sn0;
                if (dorope) { const int t = (int)(row - TCTX) & 4095; const int pos = (wc & 1) ? (t & 63) : (t >> 6);
                    const float* rp = rope + pos * 32 + 8 * (fq & 1); const float sg = (fq < 2) ? -1.0f : 1.0f;
                    cs0 = *(const f32x4*)rp; cs1 = *(const f32x4*)(rp + 4); sn0 = *(const f32x4*)(rp + 16) * sg; sn1 = *(const f32x4*)(rp + 20) * sg; }
#pragma unroll
                for (int bj = 0; bj < 2; ++bj) {
                    f32x4 v0 = acc[ai][bj][m][0], v1 = acc[ai][bj][m][1];
                    if (fo) {
                        float* fp = fo + ((size_t)(u.pm * 4 + layer) * 256 + rt) * 512 + (u.pn & 1) * 256 + bj * 128 + cq;
                        *(f32x4*)fp = v0; *(f32x4*)(fp + 4) = v1;
                    }
                    if (dorope) {
                        f32x4 p0, p1;
#pragma unroll
                        for (int j = 0; j < 4; ++j) { p0[j] = __shfl_xor(v0[j], 32); p1[j] = __shfl_xor(v1[j], 32); }
                        v0 = v0 * cs0 + p0 * sn0; v1 = v1 * cs1 + p1 * sn1;
                    }
                    if (mode == 1) {
#pragma unroll
                        for (int j = 0; j < 4; ++j) { v0[j] = siluf_(v0[j]); v1[j] = siluf_(v1[j]); }
                    } else if (mode == 2) {
#pragma unroll
                        for (int j = 0; j < 4; ++j) { v0[j] = einvsig_(v0[j]); v1[j] = einvsig_(v1[j]); }
                    } else if (mode == 3) { v0 = v0 * QSCALE; v1 = v1 * QSCALE; }
                    u32x4 w; w.x = pk2(v0[0], v0[1]); w.y = pk2(v0[2], v0[3]); w.z = pk2(v1[0], v1[1]); w.w = pk2(v1[2], v1[3]);
                    *(u32x4*)(arow + bj * bstride) = w;
                }
            }
    }
};
struct EpiInT {
    static constexpr bool HOOK = false;
    bf16_t* XT; float* out_dv; float* out_nv; int layer;
    __device__ __forceinline__ void operator()(EPI_ARGS) const {
        float* fo = nullptr;
        if (u.pn < 32 && u.pm >= 2) fo = (u.pm < 4) ? out_dv : out_nv;
        const int cq = wc * 32 + 8 * fq;
#pragma unroll
        for (int ai = 0; ai < 2; ++ai)
#pragma unroll
            for (int m = 0; m < 4; ++m) {
                const int rt = ai * 128 + wr * 64 + m * 16 + fr;
                const int feat = u.pm * 256 + rt;
                bf16_t* xrow = XT + (size_t)feat * TOK + (size_t)u.pn * 256 + cq;
#pragma unroll
                for (int bj = 0; bj < 2; ++bj) {
                    const f32x4 v0 = acc[ai][bj][m][0], v1 = acc[ai][bj][m][1];
                    u32x4 w; w.x = pk2(v0[0], v0[1]); w.y = pk2(v0[2], v0[3]); w.z = pk2(v1[0], v1[1]); w.w = pk2(v1[2], v1[3]);
                    *(u32x4*)(xrow + bj * 128) = w;
                    if (fo) { const int s0 = bj * 128 + cq; const int f512 = feat & 511;
                        float* fp = fo + ((size_t)(u.pn * 4 + layer) * 256 + s0) * 512 + f512;
                        fp[0] = v0[0]; fp[512] = v0[1]; fp[1024] = v0[2]; fp[1536] = v0[3];
                        fp[2048] = v1[0]; fp[2560] = v1[1]; fp[3072] = v1[2]; fp[3584] = v1[3]; }
                }
            }
    }
};
struct EpiCdft {
    static constexpr bool HOOK = false;
    bf16_t* YTC; bf16_t* YTL;
    __device__ __forceinline__ void operator()(EPI_ARGS) const {
        const int g = u.pm >> 1, part = u.pm & 1;
        bf16_t* base; size_t ld;
        if (u.pn < 32) { base = YTC + ((size_t)u.pn * 1024 + g * 256) * 512 + part * 256; ld = 512; }
        else { const int q = u.pn - 32; base = YTL + ((size_t)(q >> 4) * 1024 + g * 256) * 8192 + part * 4096 + (q & 15) * 256; ld = 8192; }
#pragma unroll
        for (int ai = 0; ai < 2; ++ai)
#pragma unroll
            for (int m = 0; m < 4; ++m) {
                const int rt = ai * 128 + wr * 64 + m * 16 + fr;
                bf16_t* yrow = base + (size_t)rt * ld + wc * 32 + 8 * fq;
#pragma unroll
                for (int bj = 0; bj < 2; ++bj) { const f32x4 v0 = acc[ai][bj][m][0], v1 = acc[ai][bj][m][1];
                    u32x4 w; w.x = pk2(v0[0], v0[1]); w.y = pk2(v0[2], v0[3]); w.z = pk2(v1[0], v1[1]); w.w = pk2(v1[2], v1[3]);
                    *(u32x4*)(yrow + bj * 128) = w; }
            }
    }
};
struct EpiPdftCtx {
    static constexpr bool HOOK = false;
    const bf16_t* ACT; bf16_t* YCAT; int tokbase, xstride;
    __device__ __forceinline__ void operator()(EPI_ARGS) const {
        const unsigned r0 = (unsigned)tokbase + (unsigned)u.x * xstride + (unsigned)u.pm * 256 + wr * 64 + fr;
        const unsigned c0 = u.pn * 256 + wc * 32 + 8 * fq;
        const bf16_t* gft = ACT + (size_t)(((tokbase + u.x * xstride) >> 8) + u.pm) * GF_TILES * GF_TILE + (size_t)u.pn * GF_TILE;
#pragma unroll
        for (int ai = 0; ai < 2; ++ai) {
            u32x4 gt[4][2];
#pragma unroll
            for (int m = 0; m < 4; ++m)
#pragma unroll
                for (int bj = 0; bj < 2; ++bj) gt[m][bj] = *(const u32x4*)(gft + gf_off(wr, wc, ai, m, bj, fr + 16 * fq));
#pragma unroll
            for (int m = 0; m < 4; ++m)
#pragma unroll
                for (int bj = 0; bj < 2; ++bj) { const f32x4 v0 = acc[ai][bj][m][0], v1 = acc[ai][bj][m][1]; const u32x4 g = gt[m][bj];
                    u32x4 w; w.x = pk2(v0[0] * bflo(g.x), v0[1] * bfhi(g.x)); w.y = pk2(v0[2] * bflo(g.y), v0[3] * bfhi(g.y));
                    w.z = pk2(v1[0] * bflo(g.z), v1[1] * bfhi(g.z)); w.w = pk2(v1[2] * bflo(g.w), v1[3] * bfhi(g.w));
                    *(u32x4*)(YCAT + (size_t)(r0 + ai * 128 + m * 16) * LDY + Y_F + c0 + bj * 128) = w; }
        }
    }
};
struct EpiPdftLat {
    static constexpr bool HOOK = false;
    float* PF;
    __device__ __forceinline__ void operator()(EPI_ARGS) const {
        const int part = u.x >> 1, b = u.x & 1;
#pragma unroll
        for (int ai = 0; ai < 2; ++ai)
#pragma unroll
            for (int m = 0; m < 4; ++m) {
                const int rt = ai * 128 + wr * 64 + m * 16 + fr;
                float* prow = PF + ((size_t)part * 8192 + (size_t)b * 4096 + (size_t)u.pm * 256 + rt) * 1024 + u.pn * 256 + wc * 32 + 8 * fq;
#pragma unroll
                for (int bj = 0; bj < 2; ++bj) { *(f32x4*)(prow + bj * 128) = acc[ai][bj][m][0]; *(f32x4*)(prow + bj * 128 + 4) = acc[ai][bj][m][1]; }
            }
    }
};
struct EpiMix {
    static constexpr bool HOOK = true;
    const bf16_t* ACT; bf16_t* MIXB;
    __device__ __forceinline__ bool want(int t) const { return t == 8 || t == 16 || t == 24; }
    __device__ __forceinline__ void hook(f32x4 (&acc)[2][2][4][2], const Unit& u, int t, int wr, int wc, int fr, int fq) const {
        const int b = (t >> 3) - 1;
        unsigned r0 = (unsigned)u.pm * 256 + wr * 64 + fr, cq = wc * 32 + 8 * fq; int lane_ = fr + 16 * fq;
        asm volatile("" : "+v"(r0), "+v"(cq), "+v"(lane_));
        const bf16_t* gp = ACT + (size_t)(u.pm * GF_TILES + 4 + b * 4 + u.pn) * GF_TILE;
        (void)r0; (void)cq;
        u32x4 ga[2][2][2], gb[2][2][2];
#define MIX_LD(buf, ai, mp) do { _Pragma("unroll") for (int mm = 0; mm < 2; ++mm) _Pragma("unroll") for (int bj = 0; bj < 2; ++bj) { \
            const bf16_t* p = gp + gf_off(wr, wc, ai, (mp) * 2 + mm, bj, lane_); ga[buf][mm][bj] = *(const u32x4*)p; gb[buf][mm][bj] = *(const u32x4*)(p + 4 * GF_TILE); } } while (0)
#define MIX_AP(buf, ai, mp) do { _Pragma("unroll") for (int mm = 0; mm < 2; ++mm) _Pragma("unroll") for (int bj = 0; bj < 2; ++bj) { \
            const u32x4 a = ga[buf][mm][bj], d = gb[buf][mm][bj]; f32x4& v0 = acc[ai][bj][(mp) * 2 + mm][0]; f32x4& v1 = acc[ai][bj][(mp) * 2 + mm][1]; \
            v0[0] *= bflo(d.x) * __builtin_amdgcn_rcpf(bflo(a.x)); v0[1] *= bfhi(d.x) * __builtin_amdgcn_rcpf(bfhi(a.x)); \
            v0[2] *= bflo(d.y) * __builtin_amdgcn_rcpf(bflo(a.y)); v0[3] *= bfhi(d.y) * __builtin_amdgcn_rcpf(bfhi(a.y)); \
            v1[0] *= bflo(d.z) * __builtin_amdgcn_rcpf(bflo(a.z)); v1[1] *= bfhi(d.z) * __builtin_amdgcn_rcpf(bfhi(a.z)); \
            v1[2] *= bflo(d.w) * __builtin_amdgcn_rcpf(bflo(a.w)); v1[3] *= bfhi(d.w) * __builtin_amdgcn_rcpf(bfhi(a.w)); } } while (0)
        MIX_LD(0, 0, 0); MIX_LD(1, 0, 1);
        MIX_AP(0, 0, 0); asm volatile("" ::: "memory"); MIX_LD(0, 1, 0);
        MIX_AP(1, 0, 1); asm volatile("" ::: "memory"); MIX_LD(1, 1, 1);
        MIX_AP(0, 1, 0); MIX_AP(1, 1, 1);
        asm volatile("" ::: "memory");
#undef MIX_LD
#undef MIX_AP
    }
    __device__ __forceinline__ void operator()(EPI_ARGS) const {
        const unsigned r0 = (unsigned)u.pm * 256 + wr * 64 + fr;
        const unsigned c0 = u.pn * 256 + wc * 32 + 8 * fq;
        const bf16_t* gp = ACT + (size_t)(u.pm * GF_TILES + 4 + 12 + u.pn) * GF_TILE;
#pragma unroll
        for (int ai = 0; ai < 2; ++ai) {
            u32x4 ga[4][2];
#pragma unroll
            for (int m = 0; m < 4; ++m)
#pragma unroll
                for (int bj = 0; bj < 2; ++bj) ga[m][bj] = *(const u32x4*)(gp + gf_off(wr, wc, ai, m, bj, fr + 16 * fq));
#pragma unroll
            for (int m = 0; m < 4; ++m)
#pragma unroll
                for (int bj = 0; bj < 2; ++bj) { const f32x4 v0 = acc[ai][bj][m][0], v1 = acc[ai][bj][m][1]; const u32x4 a = ga[m][bj];
#define RC_(x) __builtin_amdgcn_rcpf(x)
                    u32x4 w; w.x = pk2(v0[0] * RC_(bflo(a.x)), v0[1] * RC_(bfhi(a.x))); w.y = pk2(v0[2] * RC_(bflo(a.y)), v0[3] * RC_(bfhi(a.y)));
                    w.z = pk2(v1[0] * RC_(bflo(a.z)), v1[1] * RC_(bfhi(a.z))); w.w = pk2(v1[2] * RC_(bflo(a.w)), v1[3] * RC_(bfhi(a.w)));
#undef RC_
                    *(u32x4*)(MIXB + (size_t)(r0 + ai * 128 + m * 16) * 1024 + c0 + bj * 128) = w; }
        }
    }
};
struct EpiOut {
    static constexpr bool HOOK = false;
    bf16_t* O;
    __device__ __forceinline__ void operator()(EPI_ARGS) const {
#pragma unroll
        for (int ai = 0; ai < 2; ++ai)
#pragma unroll
            for (int m = 0; m < 4; ++m) {
                const int rt = ai * 128 + wr * 64 + m * 16 + fr;
                bf16_t* orow = O + ((size_t)u.pm * 256 + rt) * 1024 + u.pn * 256 + wc * 32 + 8 * fq;
#pragma unroll
                for (int bj = 0; bj < 2; ++bj) { const f32x4 v0 = acc[ai][bj][m][0], v1 = acc[ai][bj][m][1];
                    u32x4 w; w.x = pk2(v0[0], v0[1]); w.y = pk2(v0[2], v0[3]); w.z = pk2(v1[0], v1[1]); w.w = pk2(v1[2], v1[3]);
                    *(u32x4*)(orow + bj * 128) = w; }
            }
    }
};

struct KVSrc { const bf16_t* k0; int ldk0; const bf16_t* v0; int ldv0; int n0; const bf16_t* k1; int ldk1; const bf16_t* v1; int ldv1; };

#define MFMA32(a, b, c) __builtin_amdgcn_mfma_f32_32x32x16_bf16((a), (b), (c), 0, 0, 0)

template <int DV, int KW, int MODE, int NVS>
__device__ __forceinline__ void attn_core(LAS unsigned char* lds, const bf16_t* qrow, const KVSrc& S, int nT, int kcol, int vrow,
                                          const LAS float* rpbh, int dr0, int qc, f32x16 (&o)[DV / 32], float& lsum) {
    constexpr int KS = KW + 8, VS = 72, NCH = KW / 64;
    constexpr int KBYTES = 64 * KS * 2, VBYTES = KW * VS * 2;
    constexpr bool SKEW = (NVS == 3);
    static_assert(2 * KBYTES + NVS * VBYTES <= 141312, "attention LDS");
    const int tid = ltid(), lane = tid & 63, r32 = lane & 31, hi = lane >> 5;
    const bool late = SKEW && (__builtin_amdgcn_readfirstlane(tid >> 6) >= 4);
    u32x4 kr[NCH], vr[NCH];
#define A_GLOAD(t) do { const bf16_t* kp_; const bf16_t* vp_; int lk_, lv_; \
        if ((t) < S.n0) { kp_ = S.k0 + (size_t)(t) * 64 * S.ldk0; lk_ = S.ldk0; vp_ = S.v0 + (size_t)(t) * 64; lv_ = S.ldv0; } \
        else { kp_ = S.k1 + (size_t)((t) - S.n0) * 64 * S.ldk1; lk_ = S.ldk1; vp_ = S.v1 + (size_t)((t) - S.n0) * 64; lv_ = S.ldv1; } \
        _Pragma("unroll") for (int c_ = 0; c_ < NCH; ++c_) { const int id_ = tid + NTHR * c_; \
            kr[c_] = *(const u32x4*)(kp_ + (size_t)(id_ / (KW / 8)) * lk_ + (id_ % (KW / 8)) * 8); \
            vr[c_] = *(const u32x4*)(vp_ + (size_t)(id_ >> 3) * lv_ + (id_ & 7) * 8); } } while (0)
#define A_LSTORE(kslot, vslot) do { LAS bf16_t* kt_ = (LAS bf16_t*)(lds + (kslot) * KBYTES); LAS bf16_t* vt_ = (LAS bf16_t*)(lds + 2 * KBYTES + (vslot) * VBYTES); \
        _Pragma("unroll") for (int c_ = 0; c_ < NCH; ++c_) { const int id_ = tid + NTHR * c_; \
            *(LAS u32x4*)(kt_ + (id_ / (KW / 8)) * KS + (id_ % (KW / 8)) * 8) = kr[c_]; \
            { LAS bf16_t* vd_ = vt_ + (id_ >> 3) * VS + 16 * ((id_ & 7) >> 1) + 4 * (id_ & 1); \
              *(LAS u32x2*)vd_ = (u32x2){vr[c_].x, vr[c_].y}; *(LAS u32x2*)(vd_ + 8) = (u32x2){vr[c_].z, vr[c_].w}; } } } while (0)
#define A_PV(vslot) do { const LAS bf16_t* Vt_ = (const LAS bf16_t*)(lds + 2 * KBYTES + (vslot) * VBYTES); \
        _Pragma("unroll") for (int b = 0; b < DV / 32; ++b) { const LAS bf16_t* vp = Vt_ + (vrow + 32 * b + r32) * VS + 8 * hi; \
            _Pragma("unroll") for (int kh = 0; kh < 2; ++kh) _Pragma("unroll") for (int s = 0; s < 2; ++s) { \
                const bf16x8 va = *(const LAS bf16x8*)(vp + 32 * kh + 16 * s); o[b] = MFMA32(va, pf[kh][s], o[b]); } } } while (0)
    bf16x8 qf[4];
#pragma unroll
    for (int d0 = 0; d0 < 4; ++d0) qf[d0] = *(const bf16x8*)(qrow + d0 * 16 + hi * 8);
    float mrun = 0.f; lsum = 0.f;
    f32x16 negm;
#pragma unroll
    for (int j = 0; j < 16; ++j) negm[j] = 0.f;
#pragma unroll
    for (int b = 0; b < DV / 32; ++b)
#pragma unroll
        for (int j = 0; j < 16; ++j) o[b][j] = 0.f;
    bf16x8 pf[2][2];
#pragma unroll
    for (int a_ = 0; a_ < 2; ++a_)
#pragma unroll
        for (int b_ = 0; b_ < 2; ++b_) pf[a_][b_] = (bf16x8){0, 0, 0, 0, 0, 0, 0, 0};
    A_GLOAD(0); A_LSTORE(0, 0); if (nT > 1) A_GLOAD(1); __syncthreads();
    int vprev = 0, vcur = 0, vnext = 1;
    for (int t = 0; t < nT; ++t) {
        const int buf = t & 1;
        if (t + 1 < nT) A_LSTORE(buf ^ 1, vnext);
        if (t + 2 < nT) A_GLOAD(t + 2);
        if (late && t > 0) A_PV(vprev);
        const LAS bf16_t* Kt = (const LAS bf16_t*)(lds + buf * KBYTES);
        f32x16 p0, p1;
#pragma unroll
        for (int d0 = 0; d0 < 4; ++d0) {
            const bf16x8 a0 = *(const LAS bf16x8*)(Kt + r32 * KS + kcol + d0 * 16 + hi * 8);
            const bf16x8 a1 = *(const LAS bf16x8*)(Kt + (32 + r32) * KS + kcol + d0 * 16 + hi * 8);
            if (d0 == 0) { p0 = MFMA32(a0, qf[0], negm); p1 = MFMA32(a1, qf[0], negm); }
            else { p0 = MFMA32(a0, qf[d0], p0); p1 = MFMA32(a1, qf[d0], p1); }
        }
        if (MODE == 2 && t < 8) {
            const int c0 = min(max(qc - 8, 0), 48);
            const LAS float* rb = rpbh + (dr0 + t + 7) * 31 + 15 - qc;
#pragma unroll
            for (int j = 0; j < 16; ++j) { const int kc = crow(j, hi);
                p0[j] = (kc >= c0 && kc < c0 + 16) ? p0[j] + rb[kc] : -INFINITY;
                const int kc1 = kc + 32;
                p1[j] = (kc1 >= c0 && kc1 < c0 + 16) ? p1[j] + rb[kc1] : -INFINITY; }
        }
        float ma = __builtin_fmaxf(__builtin_fmaxf(p0[0], p0[1]), p1[0]), mb = __builtin_fmaxf(__builtin_fmaxf(p0[2], p0[3]), p1[1]);
        ma = __builtin_fmaxf(__builtin_fmaxf(ma, p1[2]), p1[3]);
#pragma unroll
        for (int j = 4; j < 16; j += 4) { ma = __builtin_fmaxf(__builtin_fmaxf(ma, p0[j]), p0[j + 1]); mb = __builtin_fmaxf(__builtin_fmaxf(mb, p0[j + 2]), p0[j + 3]);
            ma = __builtin_fmaxf(__builtin_fmaxf(ma, p1[j]), p1[j + 1]); mb = __builtin_fmaxf(__builtin_fmaxf(mb, p1[j + 2]), p1[j + 3]); }
        float mx = __builtin_fmaxf(ma, mb);
        { auto rr_ = __builtin_amdgcn_permlane32_swap(__float_as_uint(mx), __float_as_uint(mx), false, false); mx = fmaxf(__uint_as_float(rr_[0]), __uint_as_float(rr_[1])); }
        if (t == 0 || __any(mx > 6.0f)) {
            const float dl = (t == 0) ? mx : __builtin_fmaxf(mx, 0.f);
            mrun += dl;
#pragma unroll
            for (int j = 0; j < 16; ++j) { p0[j] -= dl; p1[j] -= dl; }
            if (t > 0) { const float f = fexp2(-dl); lsum *= f;
#pragma unroll
                for (int b = 0; b < DV / 32; ++b)
#pragma unroll
                    for (int j = 0; j < 16; ++j) o[b][j] *= f; }
#pragma unroll
            for (int j = 0; j < 16; ++j) negm[j] = -mrun;
        }
        f32x2_t sa = {0.f, 0.f}, sb = {0.f, 0.f};
#pragma unroll
        for (int j = 0; j < 16; j += 2) { p0[j] = fexp2(p0[j]); p0[j + 1] = fexp2(p0[j + 1]); p1[j] = fexp2(p1[j]); p1[j + 1] = fexp2(p1[j + 1]);
            sa += (f32x2_t){p0[j], p0[j + 1]}; sb += (f32x2_t){p1[j], p1[j + 1]}; }
        sa += sb; lsum += sa[0] + sa[1];
#pragma unroll
        for (int s = 0; s < 2; ++s) {
            u32x4 w0, w1;
            w0.x = pk2(p0[8 * s + 0], p0[8 * s + 1]); w0.y = pk2(p0[8 * s + 2], p0[8 * s + 3]); w0.z = pk2(p0[8 * s + 4], p0[8 * s + 5]); w0.w = pk2(p0[8 * s + 6], p0[8 * s + 7]);
            w1.x = pk2(p1[8 * s + 0], p1[8 * s + 1]); w1.y = pk2(p1[8 * s + 2], p1[8 * s + 3]); w1.z = pk2(p1[8 * s + 4], p1[8 * s + 5]); w1.w = pk2(p1[8 * s + 6], p1[8 * s + 7]);
            pf[0][s] = __builtin_bit_cast(bf16x8, w0); pf[1][s] = __builtin_bit_cast(bf16x8, w1);
        }
        if (!late) A_PV(vcur);
        __syncthreads();
        vprev = vcur; vcur = vnext; vnext = (vnext + 1 == NVS) ? 0 : vnext + 1;
    }
    if (SKEW) { if (late) A_PV(vprev); __syncthreads(); }
#undef A_PV
#undef A_GLOAD
#undef A_LSTORE
}

__device__ __forceinline__ void attn_store64(const f32x16 (&o)[2], float lsum, const bf16_t* gate, bf16_t* yout, int hi) {
    const float l = lsum + __shfl_xor(lsum, 32); const float inv = __builtin_amdgcn_rcpf(l);
    u32x2 gt[2][4];
#pragma unroll
    for (int b = 0; b < 2; ++b)
#pragma unroll
        for (int g = 0; g < 4; ++g) gt[b][g] = *(const u32x2*)(gate + 32 * b + 8 * g + 4 * hi);
#pragma unroll
    for (int b = 0; b < 2; ++b)
#pragma unroll
        for (int g = 0; g < 4; ++g) { const int dv = 32 * b + 8 * g + 4 * hi; const u32x2 q = gt[b][g];
            u32x2 w; w.x = pk2(o[b][4 * g] * inv * siluf_(bflo(q.x)), o[b][4 * g + 1] * inv * siluf_(bfhi(q.x)));
            w.y = pk2(o[b][4 * g + 2] * inv * siluf_(bflo(q.y)), o[b][4 * g + 3] * inv * siluf_(bfhi(q.y)));
            *(u32x2*)(yout + dv) = w; }
}

__device__ __forceinline__ void diff_unit(LAS unsigned char* lds, const bf16_t* ACT, bf16_t* YCAT, const KVSrc& S, int nT, size_t tok0, int h,
                                          float lam, float lam_init, const float* subln) {
    const int tid = ltid(), wid = __builtin_amdgcn_readfirstlane(tid >> 6), lane = tid & 63, r32 = lane & 31, hi = lane >> 5;
    const int map = wid >> 2, qs = wid & 3;
    const size_t tok = tok0 + qs * 32 + r32;
    f32x16 o[4]; float lsum;
    attn_core<128, 128, 0, 3>(lds, ACT + tok * LDACT + A_DQ + h * 128 + map * 64, S, nT, map * 64, 0, nullptr, 0, 0, o, lsum);
    const float l = lsum + __shfl_xor(lsum, 32); const float inv = __builtin_amdgcn_rcpf(l);
    LAS float* X = (LAS float*)lds;
    if (map == 1) {
#pragma unroll
        for (int b = 0; b < 4; ++b)
#pragma unroll
            for (int j = 0; j < 16; ++j) X[((qs * 64) + b * 16 + j) * 64 + lane] = o[b][j] * inv;
    }
    __syncthreads();
    if (map == 0) {
        float ssq = 0.f;
#pragma unroll
        for (int b = 0; b < 4; ++b)
#pragma unroll
            for (int j = 0; j < 16; ++j) { const float d = o[b][j] * inv - lam * X[((qs * 64) + b * 16 + j) * 64 + lane]; o[b][j] = d; ssq += d * d; }
        ssq += __shfl_xor(ssq, 32);
        const float rs = rsqrtf(ssq * (1.0f / 128.0f) + EPSN) * (1.0f - lam_init);
        const bf16_t* gate = ACT + tok * LDACT + A_DG + h * 128;
        bf16_t* yout = YCAT + tok * LDY + Y_D + h * 128;
        u32x2 gt[4][4];
#pragma unroll
        for (int b = 0; b < 4; ++b)
#pragma unroll
            for (int g = 0; g < 4; ++g) gt[b][g] = *(const u32x2*)(gate + 32 * b + 8 * g + 4 * hi);
#pragma unroll
        for (int b = 0; b < 4; ++b)
#pragma unroll
            for (int g = 0; g < 4; ++g) { const int dv = 32 * b + 8 * g + 4 * hi;
                const u32x2 q = gt[b][g]; const f32x4 sg = *(const f32x4*)(subln + dv);
                u32x2 w; w.x = pk2(o[b][4 * g] * rs * sg[0] * siluf_(bflo(q.x)), o[b][4 * g + 1] * rs * sg[1] * siluf_(bfhi(q.x)));
                w.y = pk2(o[b][4 * g + 2] * rs * sg[2] * siluf_(bflo(q.y)), o[b][4 * g + 3] * rs * sg[3] * siluf_(bfhi(q.y)));
                *(u32x2*)(yout + dv) = w; }
    }
    __syncthreads();
}

__device__ __forceinline__ void spatial_unit(LAS unsigned char* lds, int chunk, const bf16_t* ACT, const bf16_t* SGVT, const bf16_t* SGW,
                                             const float* sgb, const float* sgng, bf16_t* YCAT) {
    const int tid = ltid(), wid = __builtin_amdgcn_readfirstlane(tid >> 6), lane = tid & 63, r32 = lane & 31, hi = lane >> 5;
    LAS float* part = (LAS float*)lds;
    LAS float* rr = part + 512;
    const size_t t0 = (size_t)chunk * 128;
    { const int tk = tid & 127, cq = tid >> 7; float s = 0.f;
#pragma unroll 16
      for (int c = cq * 128; c < cq * 128 + 128; ++c) { const float v = bf2f(SGVT[(size_t)c * TOK + t0 + tk]); s += v * v; }
      part[cq * 128 + tk] = s; }
    __syncthreads();
    if (tid < 128) rr[tid] = rsqrtf((part[tid] + part[128 + tid] + part[256 + tid] + part[384 + tid]) * (1.0f / 512.0f) + EPSN);
    __syncthreads();
    const int g = wid;
    const bf16_t* Wg = SGW + (size_t)g * 128 * 128;
#pragma unroll 1
    for (int cb = 0; cb < 2; ++cb) {
        bf16x8 vb[8];
        const unsigned c = g * 64 + cb * 32 + r32;
#pragma unroll
        for (int s = 0; s < 8; ++s) {
            const f32x4 r0 = *(const LAS f32x4*)(rr + 16 * s + 8 * hi), r1 = *(const LAS f32x4*)(rr + 16 * s + 8 * hi + 4);
            const u32x4 raw = *(const u32x4*)(SGVT + (size_t)c * TOK + t0 + 16 * s + 8 * hi);
            u32x4 w; w.x = pk2(bflo(raw.x) * r0[0], bfhi(raw.x) * r0[1]); w.y = pk2(bflo(raw.y) * r0[2], bfhi(raw.y) * r0[3]);
            w.z = pk2(bflo(raw.z) * r1[0], bfhi(raw.z) * r1[1]); w.w = pk2(bflo(raw.w) * r1[2], bfhi(raw.w) * r1[3]);
            vb[s] = __builtin_bit_cast(bf16x8, w);
        }
        const float gn = sgng[c];
#pragma unroll 1
        for (int pb = 0; pb < 4; ++pb) {
            f32x16 a0;
#pragma unroll
            for (int j = 0; j < 16; ++j) a0[j] = 0.f;
#pragma unroll
            for (int s = 0; s < 8; ++s) {
                const bf16x8 wa = *(const bf16x8*)(Wg + (unsigned)((pb * 32 + r32) * 128 + 16 * s + 8 * hi));
                a0 = MFMA32(wa, vb[s], a0);
            }
            unsigned short uu[16], gg[16]; float bb[16];
#pragma unroll
            for (int j = 0; j < 16; ++j) { const int p = pb * 32 + crow(j, hi); const unsigned tok = (unsigned)t0 + p;
                uu[j] = ACT[tok * (unsigned)LDACT + A_SGU + c]; gg[j] = ACT[tok * (unsigned)LDACT + A_SGG + c]; bb[j] = sgb[g * 128 + p]; }
#pragma unroll
            for (int j = 0; j < 16; ++j) { const int p = pb * 32 + crow(j, hi); const unsigned tok = (unsigned)t0 + p;
                const float sv = a0[j] * gn + bb[j];
                YCAT[tok * (unsigned)LDY + Y_SG + c] = (bf16_t)f2bf(bf2f(uu[j]) * sv * siluf_(bf2f(gg[j]))); }
        }
    }
    __syncthreads();
}

__device__ __forceinline__ void transpose_item(const float* W, int K, int N, bf16_t* WT, int ldt, int item, int lane, LAS float* scr, bool permute) {
    const int nblk = N / 32, kb = item / nblk, nb = item % nblk, k0 = 64 * kb, n0 = 32 * nb;
#pragma unroll 8
    for (int i = 0; i < 32; ++i) { const int kk = 2 * i + (lane >> 5); scr[kk * 33 + (lane & 31)] = W[(size_t)(k0 + kk) * N + n0 + (lane & 31)]; }
    asm volatile("s_waitcnt lgkmcnt(0)" ::: "memory");
    int d0 = n0;
    if (permute) { const int s = n0 >> 9; int ds;
        if (s == 1) ds = 18; else if (s == 5) ds = 19; else if (s == 9) ds = 20; else ds = s - (s > 9 ? 3 : s > 5 ? 2 : s > 1 ? 1 : 0);
        d0 = ds * 512 + (n0 & 511); }
    const int c = lane & 7;
#pragma unroll
    for (int j = 0; j < 4; ++j) { const int n = (lane >> 3) + 8 * j; const LAS float* s = scr + (8 * c) * 33 + n;
        u32x4 o; o.x = pk2(s[0 * 33], s[1 * 33]); o.y = pk2(s[2 * 33], s[3 * 33]); o.z = pk2(s[4 * 33], s[5 * 33]); o.w = pk2(s[6 * 33], s[7 * 33]);
        *(u32x4*)(WT + (size_t)(d0 + n) * ldt + k0 + 8 * c) = o; }
    asm volatile("s_waitcnt lgkmcnt(0)" ::: "memory");
}

__device__ __forceinline__ void convert_layer_weights(int l, LAS unsigned char* lds) {
    KPARAMS;
    const int tid = ltid(), wave = tid >> 6, lane = tid & 63;
    LAS float* scr = (LAS float*)(lds + wave * 16384);
    const int gw = blockIdx.x * 8 + wave, NGW = gridDim.x * 8;
    unsigned char* ws_ = lws(P); bf16_t* WIN = (bf16_t*)(ws_ + WS_WIN); bf16_t* WP = (bf16_t*)(ws_ + WS_WP); bf16_t* WO = (bf16_t*)(ws_ + WS_WO);
    constexpr int I_IN = 16 * 336, I_P = 8 * 32, I_F = 16 * 32, I_O = 16 * 32, NIT = I_IN + 3 * I_P + I_F + I_O;
    for (int it = gw; it < NIT; it += NGW) {
        int r = it;
        if (r < I_IN) { transpose_item(P.in[I_WIN] + (size_t)l * 1024 * NIN, 1024, NIN, WIN, 1024, r, lane, scr, true); continue; } r -= I_IN;
        if (r < I_P) { transpose_item(P.in[I_PSG] + (size_t)l * 512 * 1024, 512, 1024, WP, LDY, r, lane, scr, false); continue; } r -= I_P;
        if (r < I_P) { transpose_item(P.in[I_PDIFF] + (size_t)l * 512 * 1024, 512, 1024, WP + 512, LDY, r, lane, scr, false); continue; } r -= I_P;
        if (r < I_P) { transpose_item(P.in[I_PNA] + (size_t)l * 512 * 1024, 512, 1024, WP + 1024, LDY, r, lane, scr, false); continue; } r -= I_P;
        if (r < I_F) { transpose_item(P.in[I_PFNET] + (size_t)l * 1024 * 1024, 1024, 1024, WP + 1536, LDY, r, lane, scr, false); continue; } r -= I_F;
        transpose_item(P.in[I_WOUT] + (size_t)l * 1024 * 1024, 1024, 1024, WO, 1024, r, lane, scr, false);
    }
}

__device__ __forceinline__ void p1_rows(int l) {
    KPARAMS;
    const int tid = ltid(), wave = tid >> 6, lane = tid & 63;
    const int gw = blockIdx.x * 8 + wave, NGW = gridDim.x * 8;
    const float* MOD = (const float*)(P.ws + WS_MOD);
    const bf16_t* OUTRAW = (const bf16_t*)(P.ws + WS_ACT);
    bf16_t* HB = (bf16_t*)(P.ws + WS_R1);
#pragma unroll 1
    for (int t0 = gw; t0 < TOK; t0 += 2 * NGW) {
        f32x4 x[2][4]; u32x2 rq[2][4];
        int tt[2], cvv[2];
#pragma unroll
        for (int q = 0; q < 2; ++q) { int t = t0 + q * NGW; tt[q] = t; if (t >= TOK) t = t0; cvv[q] = t < TCTX ? 0 : 1 + ((t - TCTX) >> 12);
            const float* xs = (l <= 1) ? (t < TCTX ? P.in[I_XP] + (size_t)t * DM : P.in[I_XS] + (size_t)(t - TCTX) * DM) : P.out + (size_t)t * DM;
#pragma unroll
            for (int j = 0; j < 4; ++j) x[q][j] = *(const f32x4*)(xs + 4 * lane + 256 * j);
            if (l >= 1) {
#pragma unroll
                for (int j = 0; j < 4; ++j) rq[q][j] = *(const u32x2*)(OUTRAW + (size_t)t * DM + 4 * lane + 256 * j); } }
#pragma unroll
        for (int q = 0; q < 2; ++q) { const int t = tt[q], cv = cvv[q];
            if (t >= TOK) continue;
            if (l >= 1) {
                f32x4 r[4]; float s = 0.f;
#pragma unroll
                for (int j = 0; j < 4; ++j) { const u32x2 w = rq[q][j]; r[j] = (f32x4){bflo(w.x), bfhi(w.x), bflo(w.y), bfhi(w.y)}; s += r[j][0] * r[j][0] + r[j][1] * r[j][1] + r[j][2] * r[j][2] + r[j][3] * r[j][3]; }
                const float rs = rsqrtf(wave_sum(s) * (1.0f / DM) + EPSN);
                const float* gate = MOD + ((size_t)(l - 1) * 3 + cv) * 3072 + 2048;
                const float* gp = P.in[I_GPOST] + (size_t)(l - 1) * DM;
#pragma unroll
                for (int j = 0; j < 4; ++j) { const f32x4 gt = *(const f32x4*)(gate + 4 * lane + 256 * j), gg = *(const f32x4*)(gp + 4 * lane + 256 * j);
                    x[q][j] = x[q][j] + gt * (r[j] * rs * gg);
                    *(f32x4*)(P.out + (size_t)t * DM + 4 * lane + 256 * j) = x[q][j]; }
            }
            if (l < 4) {
                float s = 0.f;
#pragma unroll
                for (int j = 0; j < 4; ++j) s += x[q][j][0] * x[q][j][0] + x[q][j][1] * x[q][j][1] + x[q][j][2] * x[q][j][2] + x[q][j][3] * x[q][j][3];
                const float rs = rsqrtf(wave_sum(s) * (1.0f / DM) + EPSN);
                const float* md = MOD + ((size_t)l * 3 + cv) * 3072;
                const float* gp = P.in[I_GPRE] + (size_t)l * DM;
#pragma unroll
                for (int j = 0; j < 4; ++j) { const int c = 4 * lane + 256 * j;
                    const f32x4 sh = *(const f32x4*)(md + c), sc = *(const f32x4*)(md + 1024 + c), gg = *(const f32x4*)(gp + c);
                    const f32x4 hh = x[q][j] * rs * gg * (sc + 1.0f) + sh;
                    u32x2 w; w.x = pk2(hh[0], hh[1]); w.y = pk2(hh[2], hh[3]);
                    *(u32x2*)(HB + (size_t)t * DM + c) = w; }
            }
        }
    }
}

__device__ __forceinline__ void prologue(LAS unsigned char* lds) {
    KPARAMS;
    const int tid = ltid(), wave = tid >> 6, lane = tid & 63;
    const size_t gt = (size_t)blockIdx.x * NTHR + tid, GT = (size_t)gridDim.x * NTHR;
    LAS float* tab = (LAS float*)lds;
    for (int k = tid; k < 4096; k += NTHR) tab[k] = cosf((float)k * (6.283185307179586f / 4096.0f)) * (1.0f / 64.0f);
    __syncthreads();
    {
        bf16_t* CSL = (bf16_t*)(P.ws + WS_CSL);
        for (size_t e = gt; e < (size_t)4096 * 512; e += GT) { const int i = (int)(e >> 9), j0 = (int)(e & 511) * 8;
            u32x4 wc, ws; unsigned* pc = (unsigned*)&wc; unsigned* ps = (unsigned*)&ws;
#pragma unroll
            for (int q = 0; q < 4; ++q) { const int i0 = (i * (j0 + 2 * q)) & 4095, i1 = (i * (j0 + 2 * q + 1)) & 4095;
                pc[q] = pk2(tab[i0], tab[i1]); ps[q] = pk2(tab[(i0 + 1024) & 4095], tab[(i1 + 1024) & 4095]); }
            *(u32x4*)(CSL + (size_t)i * 8192 + j0) = wc; *(u32x4*)(CSL + (size_t)i * 8192 + 4096 + j0) = ws; }
        bf16_t* CS256 = (bf16_t*)(P.ws + WS_CS256); bf16_t* CSP = (bf16_t*)(P.ws + WS_CSP256);
        for (size_t e = gt; e < 256 * 256; e += GT) { const int j = (int)(e >> 8), k = (int)(e & 255); const int idx = ((j * k) & 255) * 16;
            const float cv = tab[idx] * 4.0f, sv = tab[(idx + 3072) & 4095] * 4.0f;
            CS256[j * 256 + k] = (bf16_t)f2bf(cv); CS256[(256 + j) * 256 + k] = (bf16_t)f2bf(sv);
            CSP[j * 512 + k] = (bf16_t)f2bf(cv); CSP[j * 512 + 256 + k] = (bf16_t)f2bf(-sv); }
    }
    {
        float* ROPE = (float*)(P.ws + WS_ROPE);
        for (size_t e = gt; e < 64 * 16; e += GT) { const int pos = (int)(e >> 4), f = (int)(e & 15);
            const float inv = powf(10000.0f, -(float)f / 16.0f); const float ang = (float)pos * inv;
            ROPE[pos * 32 + f] = cosf(ang); ROPE[pos * 32 + 16 + f] = sinf(ang); }
        float* RPB = (float*)(P.ws + WS_RPB);
        for (size_t e = gt; e < 4 * 8 * 15 * 31; e += GT) RPB[e] = P.in[I_RPB][e] * LOG2E;
        bf16_t* SGW = (bf16_t*)(P.ws + WS_SGW);
        for (size_t e = gt; e < 4 * 8 * 128 * 128; e += GT) SGW[e] = (bf16_t)f2bf(P.in[I_SGW][e]);
    }
    {
        bf16_t* CDK = (bf16_t*)(P.ws + WS_CDK); bf16_t* CNK = (bf16_t*)(P.ws + WS_CNK);
        bf16_t* CDVT = (bf16_t*)(P.ws + WS_CDVT); bf16_t* CNVT = (bf16_t*)(P.ws + WS_CNVT);
        const size_t NC4 = (size_t)2 * 4 * 512 * 512 / 4;
        for (size_t e = gt; e < NC4; e += GT) { const f32x4 a = *(const f32x4*)(P.in[I_CDK] + 4 * e), b = *(const f32x4*)(P.in[I_CNK] + 4 * e);
            u32x2 wa, wb; wa.x = pk2(a[0], a[1]); wa.y = pk2(a[2], a[3]); wb.x = pk2(b[0], b[1]); wb.y = pk2(b[2], b[3]);
            *(u32x2*)(CDK + 4 * e) = wa; *(u32x2*)(CNK + 4 * e) = wb; }
        LAS float* tl = (LAS float*)(lds + 32768);
        const int ti = tid >> 6, tj = tid & 63;
        for (int tile = blockIdx.x; tile < 1024; tile += gridDim.x) {
            const int arr = tile >> 9, r = tile & 511, bl = r >> 6, pb = (r >> 3) & 7, fb = r & 7;
            const float* src = (arr ? P.in[I_CNV] : P.in[I_CDV]) + ((size_t)(bl * 512 + pb * 64) * 512 + fb * 64);
#pragma unroll
            for (int rr = 0; rr < 8; ++rr) { const int p = rr * 8 + ti; tl[p * 65 + tj] = src[(size_t)p * 512 + tj]; }
            __syncthreads();
            bf16_t* dst = (arr ? CNVT : CDVT) + ((size_t)(bl * 512 + fb * 64) * 512 + pb * 64);
#pragma unroll
            for (int rr = 0; rr < 8; ++rr) { const int f = rr * 8 + ti; dst[(size_t)f * 512 + tj] = (bf16_t)f2bf(tl[tj * 65 + f]); }
            __syncthreads();
        }
    }
    __syncthreads();
    {
        float* MOD = (float*)(P.ws + WS_MOD);
        LAS float* red = (LAS float*)lds;
        LAS float* sc = (LAS float*)(lds + 16384);
        for (int k = tid; k < 1024; k += NTHR) { sc[k] = siluf_(P.in[I_CCTX][k]); sc[1024 + k] = siluf_(P.in[I_C][k]); sc[2048 + k] = siluf_(P.in[I_C][1024 + k]); }
        __syncthreads();
        for (int un = blockIdx.x; un < 4 * 48; un += gridDim.x) {
            const int l = un / 48, jb = un % 48; const int j = jb * 64 + lane;
            const float* w = P.in[I_WMOD] + (size_t)l * 1024 * 3072 + j;
            float a0 = 0.f, a1 = 0.f, a2 = 0.f;
#pragma unroll 1
            for (int k0 = wave * 128; k0 < wave * 128 + 128; k0 += 16) {
                float wv[16];
#pragma unroll
                for (int i = 0; i < 16; ++i) wv[i] = w[(size_t)(k0 + i) * 3072];
#pragma unroll
                for (int i = 0; i < 16; ++i) { a0 += sc[k0 + i] * wv[i]; a1 += sc[1024 + k0 + i] * wv[i]; a2 += sc[2048 + k0 + i] * wv[i]; }
            }
            red[(wave * 3 + 0) * 64 + lane] = a0; red[(wave * 3 + 1) * 64 + lane] = a1; red[(wave * 3 + 2) * 64 + lane] = a2;
            __syncthreads();
            if (tid < 192) { const int cv = tid >> 6, ln = tid & 63; float sm = 0.f;
#pragma unroll
                for (int w8 = 0; w8 < 8; ++w8) sm += red[(w8 * 3 + cv) * 64 + ln];
                MOD[((size_t)l * 3 + cv) * 3072 + jb * 64 + ln] = sm + P.in[I_BMOD][(size_t)l * 3072 + jb * 64 + ln]; }
            __syncthreads();
        }
    }
}

__device__ __forceinline__ void combine_pf() {
    KPARAMS;
    const float* PF = (const float*)(P.ws + WS_R1); const bf16_t* ACT = (const bf16_t*)(P.ws + WS_ACT); bf16_t* YCAT = (bf16_t*)(P.ws + WS_YCAT);
    const size_t gt = (size_t)blockIdx.x * NTHR + ltid(), GT = (size_t)gridDim.x * NTHR;
    for (size_t e = gt; e < (size_t)8192 * 256; e += GT) { const size_t t = e >> 8; const int c = (int)(e & 255) * 4;
        const f32x4 a = *(const f32x4*)(PF + t * 1024 + c), b = *(const f32x4*)(PF + (size_t)8192 * 1024 + t * 1024 + c);
        const size_t tok = TCTX + t;
        const u32x2 g = *(const u32x2*)(ACT + tok * LDACT + A_FG + c);
        u32x2 w; w.x = pk2((a[0] + b[0]) * bflo(g.x), (a[1] + b[1]) * bfhi(g.x)); w.y = pk2((a[2] + b[2]) * bflo(g.y), (a[3] + b[3]) * bfhi(g.y));
        *(u32x2*)(YCAT + tok * LDY + Y_F + c) = w; }
}

constexpr size_t WS_BAR = WS_SMALL + 2 * MiB + 512 * 1024;
constexpr int LDS_BARST = LDS_BYTES - 64;
#define XB_TMO      128
#define XB_XCNT(j)  (256  + 64 * (j))
#define XB_XSUB(j)  (1280 + 64 * (j))
#define XB_XGEN(j)  (2304 + 64 * (j))
#define XB_TOP      3328
#define XB_TOPGEN   3392
#define XCD_BAR_WORDS 3456
#define XB_SPIN_CAP (1u << 20)
__device__ __forceinline__ unsigned xb_ld(unsigned* p)              { return __hip_atomic_load(p, __ATOMIC_RELAXED, __HIP_MEMORY_SCOPE_AGENT); }
__device__ __forceinline__ unsigned xb_add(unsigned* p, unsigned v) { return __hip_atomic_fetch_add(p, v, __ATOMIC_RELAXED, __HIP_MEMORY_SCOPE_AGENT); }
__device__ __forceinline__ unsigned xb_xcc_id() { return (unsigned)__builtin_amdgcn_s_getreg((3 << 11) | 20) & 0xFu; }
#define XB_SPIN(cond, bar) do { unsigned _sp = 0; while (cond) { __builtin_amdgcn_s_sleep(1); \
    if ((++_sp & 255u) == 0u) { if (xb_ld(&(bar)[XB_TMO])) break; if (_sp > XB_SPIN_CAP) { atomicAdd(&(bar)[XB_TMO], 1u); break; } } } } while (0)
__device__ __forceinline__ void xcd_barrier_complete(unsigned* bar, unsigned x, unsigned& nloc, unsigned& nx) {
    const unsigned G = gridDim.x;
    unsigned sum, cnt, mine, sp = 0u;
    for (;;) {
        sum = 0u; cnt = 0u; mine = 0u;
#pragma unroll
        for (unsigned j = 0; j < 16; ++j) { const unsigned c = xb_ld(&bar[XB_XCNT(j)]); sum += c; cnt += (c > 0u) ? 1u : 0u; mine = (j == x) ? c : mine; }
        if (sum == G) break;
        __builtin_amdgcn_s_sleep(1);
        if ((++sp & 255u) == 0u) { if (xb_ld(&bar[XB_TMO])) break; if (sp > XB_SPIN_CAP) { atomicAdd(&bar[XB_TMO], 1u); break; } }
    }
    nloc = mine > 0u ? mine : 1u; nx = cnt > 0u ? cnt : 1u;
}
__device__ __forceinline__ void gbar(LAS unsigned char* lds) {
    KPARAMS;
    asm volatile("s_waitcnt vmcnt(0)" ::: "memory");
    __syncthreads();
    if (threadIdx.x == 0) {
        unsigned* bar = (unsigned*)(lws(P) + WS_BAR);
        volatile LAS unsigned* st = (volatile LAS unsigned*)(lds + LDS_BARST);
        const unsigned x = xb_xcc_id();
        __builtin_amdgcn_s_waitcnt(0);
        unsigned nloc = st[0], nx = st[1];
        if (nloc == 0u) { xcd_barrier_complete(bar, x, nloc, nx); st[0] = nloc; st[1] = nx; }
        const unsigned old = xb_add(&bar[XB_XSUB(x)], 1u);
        const unsigned gen = old / nloc;
        if (old + 1u == (gen + 1u) * nloc) {
            __builtin_amdgcn_fence(__ATOMIC_RELEASE, "agent");
            asm volatile("s_waitcnt vmcnt(0)" ::: "memory");
            const unsigned og = xb_add(&bar[XB_TOP], 1u);
            const unsigned tg = og / nx;
            if (og + 1u == (tg + 1u) * nx) xb_add(&bar[XB_TOPGEN], 1u);
            else XB_SPIN(xb_ld(&bar[XB_TOPGEN]) == tg, bar);
            __builtin_amdgcn_fence(__ATOMIC_ACQUIRE, "agent");
            xb_add(&bar[XB_XGEN(x)], 1u);
            asm volatile("s_waitcnt vmcnt(0)" ::: "memory");
        } else {
            XB_SPIN(xb_ld(&bar[XB_XGEN(x)]) == gen, bar);
            __builtin_amdgcn_fence(__ATOMIC_ACQUIRE, "agent");
            asm volatile("s_waitcnt vmcnt(0)" ::: "memory");
        }
    }
    __syncthreads();
}

#ifndef REP_P2
#define REP_P2 1
#endif
#ifndef REP_DFT
#define REP_DFT 1
#endif
#ifndef REP_DL
#define REP_DL 1
#endif
#ifndef REP_AR
#define REP_AR 1
#endif
#ifndef REP_P4
#define REP_P4 1
#endif
#ifndef REP_P5
#define REP_P5 1
#endif
#ifndef REP_CONV
#define REP_CONV 1
#endif

struct EpiC { static constexpr bool HOOK = false; EpiCdft e; __device__ __forceinline__ void operator()(EPI_ARGS) const { Unit v = u; v.pm = u.x * 2 + u.pm; e(acc, v, wr, wc, fr, fq); } };
__device__ __forceinline__ void phase2(int l, LAS unsigned char* lds) {
    KPARAMS;
    unsigned char* ws = lws(P); const int G = gridDim.x, bid = lbid();
    bf16_t* WIN = (bf16_t*)(ws + WS_WIN); bf16_t* HB = (bf16_t*)(ws + WS_R1); bf16_t* ACT = (bf16_t*)(ws + WS_ACT); bf16_t* XT = (bf16_t*)(ws + WS_R3);
#pragma unroll 1
    for (int step = 0; step < 3; ++step) {
        const int which = (bid >= (G >> 1)) ? (step == 0 ? 2 : step - 1) : step;
        if (which == 0) {
            Job J{HB, WIN, 1024, 1024, 1024, 64, 36, 1, G, bid, 256L * 1024, 0, 0, 0, 256L * 1024, 0, 1};
            EpiIn E{ACT, P.out + (size_t)1 * 16777216, P.out + (size_t)3 * 16777216, (const float*)(ws + WS_ROPE), l, (bf16_t*)(ws + WS_GF)};
            pg8::gemm_phase(lds, J, E);
        } else if (which == 1) {
            Job J{WIN + (size_t)9216 * 1024, HB, 1024, 1024, 1024, 6, 64, 1, G, bid, 256L * 1024, 0, 0, 0, 256L * 1024, 0, 0};
            EpiInT E{XT, P.out + (size_t)2 * 16777216, P.out + (size_t)4 * 16777216, l};
            pg8::gemm_phase(lds, J, E);
        } else {
            const int hG = G >> 1;
            if (bid >= hG) {
            Job J{(const bf16_t*)(ws + WS_CS256), HB, 256, 1024, 256, 2, 64, 4, hG, bid - hG, 256L * 256, 0, 0, 0, 256L * 1024, 256, 0};
            EpiC E{{(bf16_t*)(ws + WS_R2), (bf16_t*)(ws + WS_R2 + 32 * MiB)}};
            pg8::gemm_phase(lds, J, E);
            }
        }
    }
}

__device__ __forceinline__ void phase3_dft(int l, LAS unsigned char* lds) {
    KPARAMS;
    unsigned char* ws = lws(P); const int G = gridDim.x, bid = lbid(), hG = G >> 1;
    if (bid < hG) {
        Job J{(const bf16_t*)(ws + WS_CSL), (const bf16_t*)(ws + WS_R2 + 32 * MiB), 8192, 8192, 8192, 16, 4, 2, hG, bid, 256L * 8192, 0, 0, 0, 256L * 8192, 1024L * 8192, 0};
        EpiPdftCtx E{(const bf16_t*)(ws + WS_GF), (bf16_t*)(ws + WS_YCAT), TCTX, 4096};
        pg8::gemm_phase(lds, J, E);
    } else {
        Job J{(const bf16_t*)(ws + WS_CSP256), (const bf16_t*)(ws + WS_R2), 512, 512, 512, 1, 4, 32, G - hG, bid - hG, 0, 0, 0, 0, 256L * 512, 1024L * 512, 0};
        EpiPdftCtx E{(const bf16_t*)(ws + WS_GF), (bf16_t*)(ws + WS_YCAT), 0, 256};
        pg8::gemm_phase(lds, J, E);
    }
}

__device__ __forceinline__ void na_unit(int l, int id, LAS unsigned char* lds) {
    KPARAMS;
    unsigned char* ws = lws(P);
    const bf16_t* ACT = (const bf16_t*)(ws + WS_ACT); const bf16_t* XT = (const bf16_t*)(ws + WS_R3); bf16_t* YCAT = (bf16_t*)(ws + WS_YCAT);
    const int tid = ltid(), wid = __builtin_amdgcn_readfirstlane(tid >> 6), lane = tid & 63, r32 = lane & 31, hi = lane >> 5;
        const int xc = id & 7, jj = id >> 3, b = xc >> 2, hg = (xc >> 1) & 1, r = (xc & 1) * 32 + jj;
        const int r0 = min(max(r - 4, 0), 56);
        const size_t base = TCTX + (size_t)b * 4096;
        KVSrc S{ACT + (base + (size_t)r0 * 64) * LDACT + A_NK + hg * 256, LDACT, XT + (size_t)(1024 + hg * 256) * TOK + base + (size_t)r0 * 64, TOK, 8,
                (const bf16_t*)(ws + WS_CNK) + ((size_t)(b * 4 + l) * 512) * 512 + hg * 256, 512, (const bf16_t*)(ws + WS_CNVT) + ((size_t)(b * 4 + l) * 512 + hg * 256) * 512, 512};
        const int hl = wid >> 1, qh = wid & 1, h = hg * 4 + hl, qc = qh * 32 + r32;
        const size_t tok = base + (size_t)r * 64 + qc;
        f32x16 o[2]; float lsum;
        LAS float* rpbl = (LAS float*)(lds + 141312);
        { const float* rsrc = (const float*)(ws + WS_RPB) + (size_t)(l * 8 + hg * 4) * 15 * 31;
          for (int i = tid; i < 4 * 15 * 31; i += NTHR) rpbl[i] = rsrc[i]; }
        attn_core<64, 256, 2, 2>(lds, ACT + tok * LDACT + A_NQ + h * 64, S, 16, hl * 64, hl * 64, rpbl + hl * 15 * 31, r0 - r, qc, o, lsum);
        attn_store64(o, lsum, ACT + tok * LDACT + A_NG + h * 64, YCAT + tok * LDY + Y_NA + h * 64, hi);
}

__device__ __forceinline__ void phase3_attn_a(int l, LAS unsigned char* lds) {
    KPARAMS;
    unsigned char* ws = lws(P); const int G = gridDim.x, bid = lbid();
    const bf16_t* ACT = (const bf16_t*)(ws + WS_ACT); const bf16_t* XT = (const bf16_t*)(ws + WS_R3); bf16_t* YCAT = (bf16_t*)(ws + WS_YCAT);
    const int tid = ltid(), wid = __builtin_amdgcn_readfirstlane(tid >> 6), lane = tid & 63, r32 = lane & 31, hi = lane >> 5;
    const float lam_init = 0.8f - 0.6f * expf(-0.3f * (float)l);
    const float d1 = wave_sum(P.in[I_LQ1][l * 64 + lane] * P.in[I_LK1][l * 64 + lane]);
    const float d2 = wave_sum(P.in[I_LQ2][l * 64 + lane] * P.in[I_LK2][l * 64 + lane]);
    const float lam = expf(d1) - expf(d2) + lam_init;
    const float* subln = P.in[I_SUBLN] + l * 128;
#pragma unroll 1
    for (int rp = 0; rp < REP_AR; ++rp) {
    if (bid >= (G >> 1)) {
#pragma unroll 1
        for (int id = bid - (G >> 1); id < 256; id += G - (G >> 1)) na_unit(l, id, lds);
    }
    for (int id = bid; id < 256; id += G) {
        const int b = id >> 3, h = (id >> 1) & 3, qh = id & 1;
        const size_t base = (size_t)b * 256;
        KVSrc S{ACT + base * LDACT + A_DK + h * 128, LDACT, XT + (size_t)(512 + h * 128) * TOK + base, TOK, 4, nullptr, 0, nullptr, 0};
        diff_unit(lds, ACT, YCAT, S, 4, base + (size_t)qh * 128, h, lam, lam_init, subln);
    }
    for (int id = bid; id < 256; id += G) {
        const int b = id >> 3, h = id & 7;
        const size_t base = (size_t)b * 256;
        KVSrc S{ACT + base * LDACT + A_NK + h * 64, LDACT, XT + (size_t)(1024 + h * 64) * TOK + base, TOK, 4, nullptr, 0, nullptr, 0};
        const size_t tok = base + wid * 32 + r32;
        f32x16 o[2]; float lsum;
        attn_core<64, 64, 0, 3>(lds, ACT + tok * LDACT + A_NQ + h * 64, S, 4, 0, 0, nullptr, 0, 0, o, lsum);
        attn_store64(o, lsum, ACT + tok * LDACT + A_NG + h * 64, YCAT + tok * LDY + Y_NA + h * 64, hi);
    }
    for (int id = G - 1 - bid; id < 128; id += G)
        spatial_unit(lds, id, ACT, XT, (const bf16_t*)(ws + WS_SGW) + (size_t)l * 8 * 128 * 128, P.in[I_SGB] + l * 1024, P.in[I_SGNG] + l * 512, YCAT);
    }
}

__device__ __forceinline__ void phase3_attn_b(int l, LAS unsigned char* lds) {
    KPARAMS;
    unsigned char* ws = lws(P); const int G = gridDim.x, bid = lbid();
    const bf16_t* ACT = (const bf16_t*)(ws + WS_ACT); const bf16_t* XT = (const bf16_t*)(ws + WS_R3); bf16_t* YCAT = (bf16_t*)(ws + WS_YCAT);
    const int tid = ltid(), wid = __builtin_amdgcn_readfirstlane(tid >> 6), lane = tid & 63, r32 = lane & 31, hi = lane >> 5;
    const float lam_init = 0.8f - 0.6f * expf(-0.3f * (float)l);
    const float d1 = wave_sum(P.in[I_LQ1][l * 64 + lane] * P.in[I_LK1][l * 64 + lane]);
    const float d2 = wave_sum(P.in[I_LQ2][l * 64 + lane] * P.in[I_LK2][l * 64 + lane]);
    const float lam = expf(d1) - expf(d2) + lam_init;
    const float* subln = P.in[I_SUBLN] + l * 128;
#pragma unroll 1
    for (int rp = 0; rp < REP_DL; ++rp)
    for (int id = bid; id < 256; id += G) {
        const int bh = id & 7, qb = id >> 3, b = bh >> 2, h = bh & 3;
        const size_t base = TCTX + (size_t)b * 4096;
        KVSrc S{ACT + base * LDACT + A_DK + h * 128, LDACT, XT + (size_t)(512 + h * 128) * TOK + base, TOK, 64,
                (const bf16_t*)(ws + WS_CDK) + ((size_t)(b * 4 + l) * 512) * 512 + h * 128, 512, (const bf16_t*)(ws + WS_CDVT) + ((size_t)(b * 4 + l) * 512 + h * 128) * 512, 512};
        diff_unit(lds, ACT, YCAT, S, 72, base + (size_t)qb * 128, h, lam, lam_init, subln);
    }
}

__device__ __forceinline__ void phase_mix(LAS unsigned char* lds) {
    KPARAMS;
    unsigned char* ws = lws(P); const int G = gridDim.x, bid = lbid();
    Job J{(const bf16_t*)(ws + WS_YCAT), (const bf16_t*)(ws + WS_WP), LDY, LDY, LDY, 64, 4, 1, G, bid, 256L * LDY, 0, 0, 0, 256L * LDY, 0, 1};
    EpiMix E{(const bf16_t*)(ws + WS_GF), (bf16_t*)(ws + WS_R3)};
    pg8::gemm_phase(lds, J, E);
}

__device__ __forceinline__ void phase5(LAS unsigned char* lds) {
    KPARAMS;
    unsigned char* ws = lws(P); const int G = gridDim.x, bid = lbid();
    Job J{(const bf16_t*)(ws + WS_R3), (const bf16_t*)(ws + WS_WO), 1024, 1024, 1024, 64, 4, 1, G, bid, 256L * 1024, 0, 0, 0, 256L * 1024, 0, 1};
    EpiOut E{(bf16_t*)(ws + WS_ACT)};
    pg8::gemm_phase(lds, J, E);
}

__global__ void __launch_bounds__(NTHR, 2) fwd_megakernel(Params P) {
    extern __shared__ __attribute__((aligned(16))) unsigned char smem[];
    LAS unsigned char* lds = (LAS unsigned char*)smem;
    cg::grid_group grid = cg::this_grid();
    if (threadIdx.x < 16) ((LAS unsigned*)(lds + LDS_BARST))[threadIdx.x] = 0u;
    if (threadIdx.x == 0) (void)xb_add((unsigned*)(P.ws + WS_BAR) + XB_XCNT(xb_xcc_id()), 1u);
    if (P.ws == nullptr) grid.sync();
    prologue(lds);
    gbar(lds);
#pragma unroll 1
    for (int l = 0; l < 4; ++l) {
#pragma unroll 1
        for (int rp = 0; rp < REP_CONV; ++rp) convert_layer_weights(l, lds);
        p1_rows(l);
        gbar(lds);
#pragma unroll 1
        for (int rp = 0; rp < REP_P2; ++rp) phase2(l, lds);
        gbar(lds);
#pragma unroll 1
        for (int rp = 0; rp < REP_DFT; ++rp) phase3_dft(l, lds);
        phase3_attn_a(l, lds);
        phase3_attn_b(l, lds);
        gbar(lds);
#pragma unroll 1
        for (int rp = 0; rp < REP_P4; ++rp) {
        if (rp) gbar(lds);
        phase_mix(lds);
        gbar(lds);
        }
#pragma unroll 1
        for (int rp = 0; rp < REP_P5; ++rp) phase5(lds);
        gbar(lds);
    }
    p1_rows(4);
}

extern "C" void kernel_launch(void* const* d_in, const int* in_sizes, int n_in, void* d_out, int out_size, void* d_ws, size_t ws_size, hipStream_t stream) {
    static int grid = 0;
    if (grid == 0) {
        if (n_in != 27 || ws_size < WS_END) { fprintf(stderr, "kernel_launch: unexpected n_in %d or ws_size %zu (< %zu)\n", n_in, ws_size, (size_t)WS_END); grid = -1; return; }
        int dev = 0, cus = 0, per_cu = 0;
        hipGetDevice(&dev);
        hipDeviceGetAttribute(&cus, hipDeviceAttributeMultiprocessorCount, dev);
        hipFuncSetAttribute((const void*)fwd_megakernel, hipFuncAttributeMaxDynamicSharedMemorySize, LDS_BYTES);
        hipOccupancyMaxActiveBlocksPerMultiprocessor(&per_cu, (const void*)fwd_megakernel, NTHR, LDS_BYTES);
        if (per_cu < 1) { fprintf(stderr, "kernel_launch: occupancy query says %d blocks/CU\n", per_cu); per_cu = 1; }
        (void)hipGetLastError();
        grid = cus;
    }
    if (grid < 0) return;
    Params p{};
    for (int i = 0; i < 27; ++i) p.in[i] = (const float*)d_in[i];
    p.out = (float*)d_out; p.ws = (unsigned char*)d_ws;
    (void)hipMemsetAsync((unsigned char*)d_ws + WS_BAR, 0, XCD_BAR_WORDS * 4, stream);
    void* args[] = {&p};
    hipError_t e = hipLaunchCooperativeKernel((const void*)fwd_megakernel, dim3(grid), dim3(NTHR), args, LDS_BYTES, stream);
    if (e != hipSuccess) fprintf(stderr, "cooperative launch failed: %s (grid %d)\n", hipGetErrorString(e), grid);
}
```
